# Optimizing an MI355X kernel written in HIP

```python
import jax
import jax.numpy as jnp
from jax import lax
import numpy as np

D_MODEL = 2048
BATCH = 1
SEQ = 8192
DEPTH = 4

HEAD_DIM = 128
D_FF = 5504
NORM_EPS = 1e-6
BLK = 128
ROPE_THETA = 500000.0
ROPE_DIM = HEAD_DIM // 4

RET_HEADS = 8
RET_DK = 128
RET_DV = 256
RET_CHUNK = 128
RET_ROPE_BASE = 10000.0

DIL_HEADS = 8
DIL_PATTERNS = ((128, 1), (512, 4), (2048, 16))

NSA_HEADS = 16
NSA_KV_HEADS = 4
CMP_LEN = 32
CMP_STRIDE = 16
CMP_HIDDEN = 256
SEL_LEN = 64
SEL_TOPK = 16
WIN_LEN = 512
FORCE_BONUS = 1e4

AB_SIZES = (RET_HEADS * RET_DK, RET_HEADS * RET_DK, RET_HEADS * RET_DV, RET_HEADS * RET_DV,
            DIL_HEADS * HEAD_DIM, DIL_HEADS * HEAD_DIM, DIL_HEADS * HEAD_DIM)
AB_IN = sum(AB_SIZES)
AB_OUT = RET_HEADS * RET_DV + DIL_HEADS * HEAD_DIM
C_SIZES = (NSA_HEADS * HEAD_DIM,) + (NSA_KV_HEADS * HEAD_DIM,) * 6 + (3 * NSA_HEADS,)
C_IN = sum(C_SIZES)
C_OUT = NSA_HEADS * HEAD_DIM

kernel_name = "hybrid_retention_dilated_nsa_macaron"


def rmsnorm(x, g):
    xf = x.astype(jnp.float32)
    y = xf * lax.rsqrt(jnp.mean(xf * xf, axis=-1, keepdims=True) + NORM_EPS)
    return (y * g.astype(jnp.float32)).astype(x.dtype)


def swiglu(x, w1, w3, w2):
    return (jax.nn.silu(x @ w1) * (x @ w3)) @ w2


def rope(x, positions, rot_dim, base):
    half = rot_dim // 2
    inv = base ** (-jnp.arange(half, dtype=jnp.float32) / half)
    ang = positions.astype(jnp.float32)[:, :, None, None] * inv
    cos, sin = jnp.cos(ang), jnp.sin(ang)
    xf = x[..., :rot_dim].astype(jnp.float32)
    x1, x2 = xf[..., :half], xf[..., half:]
    rot = jnp.concatenate([x1 * cos - x2 * sin, x2 * cos + x1 * sin], axis=-1).astype(x.dtype)
    return jnp.concatenate([rot, x[..., rot_dim:]], axis=-1)


def split_cols(p, sizes):
    offs = np.cumsum(sizes)[:-1].tolist()
    return jnp.split(p, offs, axis=-1)


def masked_softmax(s, mask):
    s = jnp.where(mask, s, -jnp.inf)
    m = jnp.max(s, axis=-1, keepdims=True)
    m = jnp.where(jnp.isfinite(m), m, 0.0)
    p = jnp.exp(s - m)
    return p / jnp.maximum(jnp.sum(p, axis=-1, keepdims=True), 1e-30)


def retention(q, k, v, g):
    b_, s_, n_h, dk = q.shape
    dv = v.shape[-1]
    c = RET_CHUNK
    n_c = s_ // c
    log_gamma = jnp.log1p(-jnp.power(2.0, -5.0 - jnp.arange(n_h, dtype=jnp.float32)))
    qc = q.reshape(b_, n_c, c, n_h, dk).astype(jnp.float32)
    kc = (k.astype(jnp.float32) * dk ** -0.5).reshape(b_, n_c, c, n_h, dk)
    vc = v.reshape(b_, n_c, c, n_h, dv).astype(jnp.float32)
    idx = jnp.arange(c, dtype=jnp.float32)
    rel = idx[:, None] - idx[None, :]
    decay = jnp.where(rel[None] >= 0.0,
                      jnp.exp(log_gamma[:, None, None] * jnp.maximum(rel, 0.0)[None]), 0.0)
    scores = jnp.einsum('bnqhd,bnkhd->bnhqk', qc, kc) * decay[None, None]
    o_inner = jnp.einsum('bnhqk,bnkhe->bnqhe', scores, vc)
    zeta = jnp.exp(log_gamma[:, None] * (c - 1.0 - idx)[None])
    kv = jnp.einsum('bnkhd,hk,bnkhe->bnhde', kc, zeta, vc)
    chunk_decay = jnp.exp(log_gamma * c)[None, :, None, None]

    def step(state, kv_i):
        return state * chunk_decay + kv_i, state

    init = jnp.zeros((b_, n_h, dk, dv), jnp.float32)
    _, prev = lax.scan(step, init, jnp.moveaxis(kv, 1, 0))
    prev = jnp.moveaxis(prev, 0, 1)
    xi = jnp.exp(log_gamma[:, None] * (idx + 1.0)[None])
    o_cross = jnp.einsum('bnqhd,bnhde,hq->bnqhe', qc, prev, xi)
    o = (o_inner + o_cross).reshape(b_, s_, n_h, dv)
    mu = jnp.mean(o, axis=-1, keepdims=True)
    var = jnp.mean(jnp.square(o - mu), axis=-1, keepdims=True)
    o = (o - mu) * lax.rsqrt(var + NORM_EPS)
    return (jax.nn.silu(g.astype(jnp.float32)) * o).astype(q.dtype)


def dilated_branch(q, k, v, dil, span, scale):
    b_, s_, n_h, dh = q.shape
    unit = dil * BLK
    s_pad = -(-s_ // unit) * unit
    length = s_pad // dil
    nb = length // BLK

    def sub(x):
        x = jnp.pad(x, ((0, 0), (0, s_pad - s_), (0, 0), (0, 0))).reshape(b_, length, dil, n_h, dh)
        return jnp.moveaxis(x, 2, 1).reshape(b_, dil, nb, BLK, n_h, dh)

    def with_prev(x):
        prev = jnp.pad(x, ((0, 0), (0, 0), (1, 0), (0, 0), (0, 0), (0, 0)))[:, :, :-1]
        return jnp.concatenate([prev, x], axis=3)

    qs = sub(q)
    kk = with_prev(sub(k))
    vv = with_prev(sub(v))
    s = jnp.einsum('brnqhd,brnkhd->brnhqk', qs, kk, preferred_element_type=jnp.float32) * scale
    qi = jnp.arange(BLK)[:, None] + BLK
    kj = jnp.arange(2 * BLK)[None, :]
    dist = qi - kj
    kglob = jnp.arange(nb)[:, None, None] * BLK + kj[None] - BLK
    mask = (dist >= 0)[None] & (dist <= span)[None] & (kglob >= 0)
    s = jnp.where(mask[None, None, :, None], s, -jnp.inf)
    m = jnp.max(s, axis=-1, keepdims=True)
    p = jnp.exp(s - m)
    den = jnp.sum(p, axis=-1, keepdims=True)
    o = jnp.einsum('brnhqk,brnkhd->brnqhd', p / den, vv.astype(jnp.float32))
    lse = jnp.swapaxes((m + jnp.log(den))[..., 0], -1, -2)
    o = jnp.moveaxis(o.reshape(b_, dil, length, n_h, dh), 1, 2).reshape(b_, s_pad, n_h, dh)[:, :s_]
    lse = jnp.moveaxis(lse.reshape(b_, dil, length, n_h), 1, 2).reshape(b_, s_pad, n_h)[:, :s_]
    return o, lse


def dilated_attention(q, k, v):
    scale = q.shape[-1] ** -0.5
    outs, lses = [], []
    for window, dil in DIL_PATTERNS:
        o, lse = dilated_branch(q, k, v, dil, window // dil, scale)
        outs.append(o)
        lses.append(lse)
    w = jax.nn.softmax(jnp.stack(lses, axis=0), axis=0)
    return jnp.sum(w[..., None] * jnp.stack(outs, axis=0), axis=0).astype(q.dtype)


def retention_dilated_mixer(h, positions, w_in, w_out):
    b_, s_, _ = h.shape
    qa, ka, va, ga, qb, kb, vb = split_cols(h @ w_in, AB_SIZES)
    qa = rope(qa.reshape(b_, s_, RET_HEADS, RET_DK), positions, RET_DK, RET_ROPE_BASE)
    ka = rope(ka.reshape(b_, s_, RET_HEADS, RET_DK), positions, RET_DK, RET_ROPE_BASE)
    oa = retention(qa, ka, va.reshape(b_, s_, RET_HEADS, RET_DV), ga.reshape(b_, s_, RET_HEADS, RET_DV))
    qb = rope(qb.reshape(b_, s_, DIL_HEADS, HEAD_DIM), positions, ROPE_DIM, ROPE_THETA)
    kb = rope(kb.reshape(b_, s_, DIL_HEADS, HEAD_DIM), positions, ROPE_DIM, ROPE_THETA)
    ob = dilated_attention(qb, kb, vb.reshape(b_, s_, DIL_HEADS, HEAD_DIM))
    cat = jnp.concatenate([oa.reshape(b_, s_, RET_HEADS * RET_DV),
                           ob.reshape(b_, s_, DIL_HEADS * HEAD_DIM)], axis=-1)
    return cat @ w_out


def nsa_attention(q, kc, vc, ks, vs, kw, vw, gates, ck_w1, ck_w2, cv_w1, cv_w2, pe_k, pe_v):
    b_, s_, n_h, dh = q.shape
    n_g = kc.shape[2]
    hpg = n_h // n_g
    scale = dh ** -0.5
    n_cmp = (s_ - CMP_LEN) // CMP_STRIDE + 1
    starts = jnp.arange(n_cmp) * CMP_STRIDE
    cmp_idx = starts[:, None] + jnp.arange(CMP_LEN)[None]
    cmp_end = starts + CMP_LEN - 1

    def compress(x, pe, w1, w2):
        blocks = x[:, cmp_idx] + pe[:, None, :]
        blocks = jnp.moveaxis(blocks, 3, 2).reshape(b_, n_cmp, n_g, CMP_LEN * dh)
        return jax.nn.gelu(blocks @ w1) @ w2

    ck = compress(kc, pe_k, ck_w1, ck_w2)
    cv = compress(vc, pe_v, cv_w1, cv_w2)
    n_sel = s_ // SEL_LEN
    n_top = min(SEL_TOPK, n_sel)
    sel_ids = jnp.arange(n_sel)
    sel_start = sel_ids * SEL_LEN
    overlap = ((starts[:, None] <= sel_start[None] + SEL_LEN - 1)
               & (cmp_end[:, None] >= sel_start[None])).astype(jnp.float32)
    kb = jnp.moveaxis(ks.reshape(b_, n_sel, SEL_LEN, n_g, dh), 3, 1)
    vb = jnp.moveaxis(vs.reshape(b_, n_sel, SEL_LEN, n_g, dh), 3, 1)
    kw_pad = jnp.pad(kw, ((0, 0), (WIN_LEN, 0), (0, 0), (0, 0)))
    vw_pad = jnp.pad(vw, ((0, 0), (WIN_LEN, 0), (0, 0), (0, 0)))
    b_idx = jnp.arange(b_)[:, None, None, None]
    g_idx = jnp.arange(n_g)[None, :, None, None]
    n_qb = s_ // BLK
    q_blocks = jnp.moveaxis(q.reshape(b_, n_qb, BLK, n_g, hpg, dh), 1, 0)
    g_blocks = jnp.moveaxis(gates.reshape(b_, n_qb, BLK, n_g, hpg, 3), 1, 0)

    def block(args):
        bi, qblk, gblk = args
        t = bi * BLK + jnp.arange(BLK)
        s = jnp.einsum('bqgjd,bngd->bgjqn', qblk, ck, preferred_element_type=jnp.float32) * scale
        p_cmp = masked_softmax(s, cmp_end[None, :] <= t[:, None])
        o_cmp = jnp.einsum('bgjqn,bngd->bqgjd', p_cmp, cv.astype(jnp.float32))
        imp = jnp.einsum('bgjqn,nm->bgqm', p_cmp, overlap)
        cur = t // SEL_LEN
        valid = sel_start[None, :] <= t[:, None]
        forced = (sel_ids[None] == 0) | (sel_ids[None] == cur[:, None]) | (sel_ids[None] == cur[:, None] - 1)
        score = jnp.where(valid, imp + jnp.where(forced, FORCE_BONUS, 0.0), -jnp.inf)
        top_val, top_idx = lax.top_k(score, n_top)
        ksel = kb[b_idx, g_idx, top_idx]
        vsel = vb[b_idx, g_idx, top_idx]
        pos = top_idx[..., None] * SEL_LEN + jnp.arange(SEL_LEN)
        smask = jnp.isfinite(top_val)[..., None] & (pos <= t[None, None, :, None, None])
        s = jnp.einsum('bqgjd,bgqnrd->bgjqnr', qblk, ksel, preferred_element_type=jnp.float32) * scale
        flat = (b_, n_g, hpg, BLK, n_top * SEL_LEN)
        p = masked_softmax(s.reshape(flat),
                           jnp.broadcast_to(smask[:, :, None], s.shape).reshape(flat))
        p = p.reshape(s.shape)
        o_slc = jnp.einsum('bgjqnr,bgqnrd->bqgjd', p, vsel.astype(jnp.float32))
        kwin = lax.dynamic_slice_in_dim(kw_pad, bi * BLK, BLK + WIN_LEN, axis=1)
        vwin = lax.dynamic_slice_in_dim(vw_pad, bi * BLK, BLK + WIN_LEN, axis=1)
        kpos = bi * BLK - WIN_LEN + jnp.arange(BLK + WIN_LEN)
        diff = t[:, None] - kpos[None]
        wmask = (diff >= 0) & (diff < WIN_LEN) & (kpos[None] >= 0)
        s = jnp.einsum('bqgjd,bkgd->bgjqk', qblk, kwin, preferred_element_type=jnp.float32) * scale
        o_win = jnp.einsum('bgjqk,bkgd->bqgjd', masked_softmax(s, wmask), vwin.astype(jnp.float32))
        gs = jax.nn.sigmoid(gblk.astype(jnp.float32))
        o = gs[..., 0:1] * o_cmp + gs[..., 1:2] * o_slc + gs[..., 2:3] * o_win
        return o.astype(q.dtype)

    out = lax.map(block, (jnp.arange(n_qb), q_blocks, g_blocks))
    return jnp.moveaxis(out, 0, 1).reshape(b_, s_, n_h * dh)


def nsa_mixer(h, positions, w_in, w_out, ck_w1, ck_w2, cv_w1, cv_w2, pe_k, pe_v):
    b_, s_, _ = h.shape
    q, kc, vc, ks, vs, kw, vw, gates = split_cols(h @ w_in, C_SIZES)
    q = rope(q.reshape(b_, s_, NSA_HEADS, HEAD_DIM), positions, ROPE_DIM, ROPE_THETA)
    kv_shape = (b_, s_, NSA_KV_HEADS, HEAD_DIM)
    kc = rope(kc.reshape(kv_shape), positions, ROPE_DIM, ROPE_THETA)
    ks = rope(ks.reshape(kv_shape), positions, ROPE_DIM, ROPE_THETA)
    kw = rope(kw.reshape(kv_shape), positions, ROPE_DIM, ROPE_THETA)
    o = nsa_attention(q, kc, vc.reshape(kv_shape), ks, vs.reshape(kv_shape), kw, vw.reshape(kv_shape),
                      gates, ck_w1, ck_w2, cv_w1, cv_w2, pe_k, pe_v)
    return o @ w_out


def setup_inputs(seed: int = 0) -> dict:
    key = jax.random.key(seed)
    ks = jax.random.split(key, 18)
    n_even = (DEPTH + 1) // 2
    n_odd = DEPTH // 2

    def w(k, shape, fan_in):
        return jax.random.normal(k, shape, jnp.float32) * fan_in ** -0.5

    x = jax.random.normal(ks[0], (BATCH, SEQ, D_MODEL), jnp.float32)
    positions = jnp.broadcast_to(jnp.arange(SEQ, dtype=jnp.int32)[None], (BATCH, SEQ))
    norm_g = 1.0 + 0.02 * jax.random.normal(ks[1], (DEPTH, 6, D_MODEL), jnp.float32)
    ffn_w1 = w(ks[2], (DEPTH, 2, D_MODEL, D_FF), D_MODEL)
    ffn_w3 = w(ks[3], (DEPTH, 2, D_MODEL, D_FF), D_MODEL)
    ffn_w2 = w(ks[4], (DEPTH, 2, D_FF, D_MODEL), D_FF)
    ab_w_in = w(ks[5], (n_even, D_MODEL, AB_IN), D_MODEL)
    ab_w_out = w(ks[6], (n_even, AB_OUT, D_MODEL), AB_OUT)
    c_w_in = w(ks[7], (n_odd, D_MODEL, C_IN), D_MODEL)
    c_w_out = w(ks[8], (n_odd, C_OUT, D_MODEL), C_OUT)
    c_ck_w1 = w(ks[9], (n_odd, CMP_LEN * HEAD_DIM, CMP_HIDDEN), CMP_LEN * HEAD_DIM)
    c_ck_w2 = w(ks[10], (n_odd, CMP_HIDDEN, HEAD_DIM), CMP_HIDDEN)
    c_cv_w1 = w(ks[11], (n_odd, CMP_LEN * HEAD_DIM, CMP_HIDDEN), CMP_LEN * HEAD_DIM)
    c_cv_w2 = w(ks[12], (n_odd, CMP_HIDDEN, HEAD_DIM), CMP_HIDDEN)
    c_pe_k = 0.02 * jax.random.normal(ks[13], (n_odd, CMP_LEN, HEAD_DIM), jnp.float32)
    c_pe_v = 0.02 * jax.random.normal(ks[14], (n_odd, CMP_LEN, HEAD_DIM), jnp.float32)
    return {"x": x, "positions": positions, "norm_g": norm_g, "ffn_w1": ffn_w1, "ffn_w3": ffn_w3,
            "ffn_w2": ffn_w2, "ab_w_in": ab_w_in, "ab_w_out": ab_w_out, "c_w_in": c_w_in,
            "c_w_out": c_w_out, "c_ck_w1": c_ck_w1, "c_ck_w2": c_ck_w2, "c_cv_w1": c_cv_w1,
            "c_cv_w2": c_cv_w2, "c_pe_k": c_pe_k, "c_pe_v": c_pe_v}


def reference(x, positions, norm_g, ffn_w1, ffn_w3, ffn_w2, ab_w_in, ab_w_out, c_w_in, c_w_out,
              c_ck_w1, c_ck_w2, c_cv_w1, c_cv_w2, c_pe_k, c_pe_v):
    for layer in range(DEPTH):
        g = norm_g[layer]
        h = rmsnorm(x, g[0])
        x = x + 0.5 * rmsnorm(swiglu(h, ffn_w1[layer, 0], ffn_w3[layer, 0], ffn_w2[layer, 0]), g[1])
        h = rmsnorm(x, g[2])
        j = layer // 2
        if layer % 2 == 0:
            m = retention_dilated_mixer(h, positions, ab_w_in[j], ab_w_out[j])
        else:
            m = nsa_mixer(h, positions, c_w_in[j], c_w_out[j], c_ck_w1[j], c_ck_w2[j],
                          c_cv_w1[j], c_cv_w2[j], c_pe_k[j], c_pe_v[j])
        x = x + rmsnorm(m, g[3])
        h = rmsnorm(x, g[4])
        x = x + 0.5 * rmsnorm(swiglu(h, ffn_w1[layer, 1], ffn_w3[layer, 1], ffn_w2[layer, 1]), g[5])
    return x
```

```cpp
#include <hip/hip_runtime.h>
#include <cstdio>
#include <cstdint>
namespace pg8 {
#define PG8_LAS __attribute__((address_space(3)))
typedef unsigned short bf16_t;
typedef short bf16x8 __attribute__((ext_vector_type(8)));
typedef float f32x4 __attribute__((ext_vector_type(4)));
typedef unsigned u32x4 __attribute__((ext_vector_type(4)));
constexpr int BM = 256, BK = 64, HALF = 128, HTB = HALF * BK * 2  , STAGE_BYTES = 8 * HTB, NXCD = 8, WGM = 8;

__host__ __device__ __forceinline__ int lds_byte(int r, int c) { const int st = (r >> 4) * 2 + (c >> 5), rr = r & 15, cc = c & 31, ob = rr * 64 + cc * 2; return st * 1024 + (ob ^ (((ob >> 9) & 1) << 5)); }
__host__ __device__ __forceinline__ void stage_rc(int b, int& R, int& C) { const int st = b / 1024, sb = b % 1024, swz = sb ^ (((sb >> 9) & 1) << 5); R = (st >> 1) * 16 + swz / 64; C = (st & 1) * 32 + (swz % 64) / 2; }
__host__ __device__ __forceinline__ int perm32(int rho) { const int n = rho >> 4, i = rho & 15; return 8 * (i >> 2) + 4 * n + (i & 3); }

struct Unit { int pm, pn; };
struct Gemm { const bf16_t* A; const bf16_t* Bt; int M, N, K; };

struct StaticOrder {
    int nM, nN, nwg, G, c;
    __host__ __device__ void init(int M, int N, int G_, int c_) { nM = M / BM; nN = N / BM; nwg = nM * nN; G = G_; c = c_; }
    __host__ __device__ bool next(int i, Unit& u) const {
        const long L = (long)i * G + c; if (L >= nwg) return false;
        int wgid = (int)L; { const int q = nwg / NXCD, r = nwg % NXCD, xcd = wgid % NXCD, off = wgid / NXCD; wgid = (xcd < r ? xcd * (q + 1) : r * (q + 1) + (xcd - r) * q) + off; }
        const int nig = WGM * nN, gid = wgid / nig, fm = gid * WGM, gsz = (nM - fm) < WGM ? (nM - fm) : WGM;
        u.pm = fm + ((wgid % nig) % gsz); u.pn = (wgid % nig) / gsz; return true;
    }
    __device__ __forceinline__ void a_ready(const Unit&) const {}
    __device__ __forceinline__ void done(const Unit&) const {}
};

__device__ __forceinline__ unsigned cvt_pk_bf16(float lo, float hi) { unsigned r; asm volatile("v_cvt_pk_bf16_f32 %0, %1, %2" : "=v"(r) : "v"(lo), "v"(hi)); return r; }
struct EpiStore {
    static constexpr bool PERM = true, AFTER_DRAIN = false;
    bf16_t* O; int ldc;
    __device__ __forceinline__ void operator()(const f32x4 (&acc)[2][2][4][2], const Unit& u, int wr, int wc, int fr, int fq) const {
        const int row0 = u.pm * BM + wr * 64 + fr, col0 = u.pn * BM + wc * 32 + 8 * fq;
#pragma unroll
        for (int ai = 0; ai < 2; ++ai)
#pragma unroll
            for (int m = 0; m < 4; ++m) { bf16_t* rowp = O + (size_t)(row0 + ai * HALF + m * 16) * ldc + col0;
#pragma unroll
                for (int bj = 0; bj < 2; ++bj) { const f32x4 v0 = acc[ai][bj][m][0], v1 = acc[ai][bj][m][1];
                    u32x4 w; w.x = cvt_pk_bf16(v0[0], v0[1]); w.y = cvt_pk_bf16(v0[2], v0[3]); w.z = cvt_pk_bf16(v1[0], v1[1]); w.w = cvt_pk_bf16(v1[2], v1[3]);
                    *(u32x4*)(rowp + bj * HALF) = w; } }
    }
};
__device__ __forceinline__ float silu_f(float a) { return a * __builtin_amdgcn_rcpf(1.0f + __expf(-a)); }
struct EpiSwiglu {
    static constexpr bool PERM = true, AFTER_DRAIN = false;
    bf16_t* O; int ldc;
    __device__ __forceinline__ void operator()(const f32x4 (&acc)[2][2][4][2], const Unit& u, int wr, int wc, int fr, int fq) const {
        const int row0 = u.pm * BM + wr * 64 + fr, col0 = u.pn * HALF + wc * 32 + 8 * fq;
#pragma unroll
        for (int ai = 0; ai < 2; ++ai)
#pragma unroll
            for (int m = 0; m < 4; ++m) { bf16_t* rowp = O + (size_t)(row0 + ai * HALF + m * 16) * ldc + col0;
                const f32x4 a0 = acc[ai][0][m][0], a1 = acc[ai][0][m][1], b0 = acc[ai][1][m][0], b1 = acc[ai][1][m][1];
                u32x4 w; w.x = cvt_pk_bf16(silu_f(a0[0]) * b0[0], silu_f(a0[1]) * b0[1]); w.y = cvt_pk_bf16(silu_f(a0[2]) * b0[2], silu_f(a0[3]) * b0[3]);
                w.z = cvt_pk_bf16(silu_f(a1[0]) * b1[0], silu_f(a1[1]) * b1[1]); w.w = cvt_pk_bf16(silu_f(a1[2]) * b1[2], silu_f(a1[3]) * b1[3]);
                *(u32x4*)rowp = w; }
    }
};

template <class Epi, class Sched, bool ALIGN_EPI = false, bool SP2 = false>
__device__ __forceinline__ void gemm_phase(PG8_LAS unsigned char* lds, const Gemm g, const Sched& S, const Epi& E) {
    int tid_l = threadIdx.x; asm volatile("" : "+v"(tid_l));
    const int tid = tid_l, wid = __builtin_amdgcn_readfirstlane(tid >> 6), lane = tid & 63, wr = wid >> 2, wc = wid & 3, fr = lane & 15, fq = lane >> 4;
    const int K = g.K, nt = K / BK;
    unsigned voffA[2], voffB[2];
#pragma unroll
    for (int i = 0; i < 2; ++i) { int R, C; stage_rc(tid * 16 + i * 8192, R, C); const int Rb = Epi::PERM ? ((R & ~31) + perm32(R & 31)) : R;
        voffA[i] = (unsigned)(R * K + C) * 2u; voffB[i] = (unsigned)(Rb * K + C) * 2u; }
    const size_t kstep = (size_t)(BK * 2);
    const size_t hstep = (size_t)HALF * K * 2;
    const size_t tstep = 2 * hstep;
    const unsigned ldsw = (unsigned)wid * 1024u;
    const int aoff = lds_byte(wr * 64 + fr, fq * 8), boff = lds_byte(wc * 32 + fr, fq * 8);
#define PG8_SA(b, h) (((b) * 2 + (h)) * HTB)
#define PG8_SB(b, h) ((4 + (b) * 2 + (h)) * HTB)
#define PG8_STAGE(bufoff, gbase, voff) do { _Pragma("unroll") for (int _i = 0; _i < 2; ++_i) \
        __builtin_amdgcn_global_load_lds((const unsigned*)((const char*)(gbase) + (voff)[_i]), (PG8_LAS unsigned*)(lds + (bufoff) + ldsw + _i * 8192), 16, 0, 0); } while (0)
#define PG8_LDA(dst, b, h) do { _Pragma("unroll") for (int m = 0; m < 4; ++m) _Pragma("unroll") for (int k = 0; k < 2; ++k) dst[m][k] = *(const PG8_LAS bf16x8*)(lds + PG8_SA(b, h) + aoff + m * 2048 + k * 1024); } while (0)
#define PG8_LDB(dst, b, h) do { _Pragma("unroll") for (int n = 0; n < 2; ++n) _Pragma("unroll") for (int k = 0; k < 2; ++k) dst[n][k] = *(const PG8_LAS bf16x8*)(lds + PG8_SB(b, h) + boff + n * 2048 + k * 1024); } while (0)
#define PG8_MMA(ai, bj, At, Bt) do { __builtin_amdgcn_s_setprio(1); _Pragma("unroll") for (int m = 0; m < 4; ++m) _Pragma("unroll") for (int n = 0; n < 2; ++n) _Pragma("unroll") for (int k = 0; k < 2; ++k) \
        acc[ai][bj][m][n] = __builtin_amdgcn_mfma_f32_16x16x32_bf16(Bt[n][k], At[m][k], acc[ai][bj][m][n], 0, 0, 0); __builtin_amdgcn_s_setprio(0); } while (0)
#define PG8_WAIT_V(n) asm volatile("s_waitcnt vmcnt(" #n ")" ::: "memory")
#define PG8_WAIT_L(n) asm volatile("s_waitcnt lgkmcnt(" #n ")" ::: "memory")
#define PG8_BAR __builtin_amdgcn_s_barrier()
#define PG8_SCHED __builtin_amdgcn_sched_barrier(0)
    Unit cur, nxt; int ui = 0;
    if (!S.next(0, cur)) return;
    f32x4 acc[2][2][4][2];
#pragma unroll
    for (int a = 0; a < 2; ++a)
#pragma unroll
        for (int b = 0; b < 2; ++b)
#pragma unroll
            for (int m = 0; m < 4; ++m)
#pragma unroll
                for (int n = 0; n < 2; ++n) acc[a][b][m][n] = (f32x4){0.f, 0.f, 0.f, 0.f};
    bf16x8 At[4][2], B0[2][2], B1[2][2];
    const char* cA = (const char*)g.A + (size_t)cur.pm * tstep; const char* cB = (const char*)g.Bt + (size_t)cur.pn * tstep;
    S.a_ready(cur);
    if constexpr (SP2) {
        PG8_STAGE(PG8_SB(0, 0), cB, voffB); PG8_STAGE(PG8_SB(0, 1), cB + hstep, voffB); PG8_STAGE(PG8_SA(0, 0), cA, voffA); PG8_STAGE(PG8_SA(0, 1), cA + hstep, voffA);
        if (wr == 1) PG8_BAR;
        PG8_WAIT_V(2); PG8_BAR;
        PG8_STAGE(PG8_SB(1, 0), cB + kstep, voffB); PG8_STAGE(PG8_SA(1, 0), cA + kstep, voffA); PG8_STAGE(PG8_SB(1, 1), cB + hstep + kstep, voffB);
        PG8_WAIT_V(6); PG8_BAR;
    } else {
        PG8_STAGE(PG8_SB(0, 0), cB, voffB); PG8_STAGE(PG8_SA(0, 0), cA, voffA); PG8_STAGE(PG8_SB(0, 1), cB + hstep, voffB); PG8_STAGE(PG8_SA(0, 1), cA + hstep, voffA);
        if (wr == 1) PG8_BAR;
        PG8_WAIT_V(4); PG8_BAR;
        PG8_STAGE(PG8_SB(1, 0), cB + kstep, voffB); PG8_STAGE(PG8_SA(1, 0), cA + kstep, voffA); PG8_STAGE(PG8_SB(1, 1), cB + hstep + kstep, voffB);
        PG8_WAIT_V(6); PG8_BAR;
    }
    for (;;) {
        const bool has_next = S.next(ui + 1, nxt);
        const char* nA = has_next ? (const char*)g.A + (size_t)nxt.pm * tstep : cA; const char* nB = has_next ? (const char*)g.Bt + (size_t)nxt.pn * tstep : cB;
        for (int t = 0; t < nt; t += 2) {
            const bool last = (t == nt - 2);
            const char* a1 = cA + (size_t)(t + 1) * kstep;
            const char* a2 = last ? nA : cA + (size_t)(t + 2) * kstep; const char* b2 = last ? nB : cB + (size_t)(t + 2) * kstep;
            const char* a3 = a2 + kstep; const char* b3 = b2 + kstep;
            if (last && has_next) S.a_ready(nxt);
            if constexpr (SP2) {
            PG8_LDB(B0, 0, 0); PG8_LDB(B1, 0, 1); PG8_SCHED; PG8_LDA(At, 0, 0); PG8_STAGE(PG8_SA(1, 1), a1 + hstep, voffA);
            PG8_WAIT_V(8); PG8_WAIT_L(0); PG8_BAR; PG8_MMA(0, 0, At, B0); PG8_MMA(0, 1, At, B1); PG8_BAR; PG8_SCHED;
            PG8_LDA(At, 0, 1); PG8_STAGE(PG8_SB(0, 0), b2, voffB); PG8_STAGE(PG8_SB(0, 1), b2 + hstep, voffB); PG8_STAGE(PG8_SA(0, 0), a2, voffA);
            PG8_WAIT_V(8); PG8_WAIT_L(0); PG8_BAR; PG8_MMA(1, 0, At, B0); PG8_MMA(1, 1, At, B1); PG8_BAR; PG8_SCHED;
            PG8_LDB(B0, 1, 0); PG8_LDB(B1, 1, 1); PG8_SCHED; PG8_LDA(At, 1, 0); PG8_STAGE(PG8_SA(0, 1), a2 + hstep, voffA);
            PG8_WAIT_V(8); PG8_WAIT_L(0); PG8_BAR; PG8_MMA(0, 0, At, B0); PG8_MMA(0, 1, At, B1); PG8_BAR; PG8_SCHED;
            PG8_LDA(At, 1, 1); PG8_STAGE(PG8_SB(1, 0), b3, voffB); PG8_STAGE(PG8_SB(1, 1), b3 + hstep, voffB); PG8_STAGE(PG8_SA(1, 0), a3, voffA);
            PG8_WAIT_V(8); PG8_WAIT_L(0); PG8_BAR; PG8_MMA(1, 0, At, B0); PG8_MMA(1, 1, At, B1); PG8_BAR; PG8_SCHED;
            } else {
            PG8_LDB(B0, 0, 0); PG8_SCHED; PG8_LDA(At, 0, 0); PG8_STAGE(PG8_SA(1, 1), a1 + hstep, voffA);
            PG8_WAIT_L(8); PG8_BAR; PG8_WAIT_L(0); PG8_MMA(0, 0, At, B0); PG8_BAR; PG8_SCHED;
            PG8_LDB(B1, 0, 1); PG8_STAGE(PG8_SB(0, 0), b2, voffB);
            PG8_BAR; PG8_WAIT_L(0); PG8_MMA(0, 1, At, B1); PG8_BAR;
            PG8_LDA(At, 0, 1); PG8_STAGE(PG8_SA(0, 0), a2, voffA);
            PG8_BAR; PG8_WAIT_L(0); PG8_MMA(1, 0, At, B0); PG8_BAR; PG8_SCHED;
            PG8_STAGE(PG8_SB(0, 1), b2 + hstep, voffB);
            PG8_WAIT_V(6); PG8_BAR; PG8_MMA(1, 1, At, B1); PG8_BAR;
            PG8_LDB(B0, 1, 0); PG8_SCHED; PG8_LDA(At, 1, 0); PG8_STAGE(PG8_SA(0, 1), a2 + hstep, voffA);
            PG8_WAIT_L(8); PG8_BAR; PG8_WAIT_L(0); PG8_MMA(0, 0, At, B0); PG8_BAR; PG8_SCHED;
            PG8_LDB(B1, 1, 1); PG8_STAGE(PG8_SB(1, 0), b3, voffB);
            PG8_BAR; PG8_WAIT_L(0); PG8_MMA(0, 1, At, B1); PG8_BAR;
            PG8_LDA(At, 1, 1); PG8_STAGE(PG8_SA(1, 0), a3, voffA);
            PG8_BAR; PG8_WAIT_L(0); PG8_MMA(1, 0, At, B0); PG8_BAR; PG8_SCHED;
            PG8_STAGE(PG8_SB(1, 1), b3 + hstep, voffB);
            PG8_WAIT_V(6); PG8_BAR; PG8_MMA(1, 1, At, B1); PG8_BAR;
            }
        }
        if constexpr (ALIGN_EPI) { if (wr == 0) PG8_BAR; }
        if constexpr (!Epi::AFTER_DRAIN) { E(acc, cur, wr, wc, fr, fq); S.done(cur); }
        if (!has_next) break;
#pragma unroll
        for (int a = 0; a < 2; ++a)
#pragma unroll
            for (int b = 0; b < 2; ++b)
#pragma unroll
                for (int m = 0; m < 4; ++m)
#pragma unroll
                    for (int n = 0; n < 2; ++n) acc[a][b][m][n] = (f32x4){0.f, 0.f, 0.f, 0.f};
        cur = nxt; cA = nA; cB = nB; ++ui;
        if constexpr (ALIGN_EPI) { if (wr == 1) PG8_BAR; }
    }
    PG8_WAIT_V(0);
    if constexpr (!ALIGN_EPI) { if (wr == 0) PG8_BAR; }
    PG8_BAR;
    if constexpr (Epi::AFTER_DRAIN) { E.fused(acc, cur, wr, wc, fr, fq, lds, wid, lane); S.done(cur); }
#undef PG8_SA
#undef PG8_SB
#undef PG8_STAGE
#undef PG8_LDA
#undef PG8_LDB
#undef PG8_MMA
#undef PG8_WAIT_V
#undef PG8_WAIT_L
#undef PG8_BAR
#undef PG8_SCHED
}
}

constexpr int S_ = 8192, D_ = 2048, DFF = 5504, DEPTH = 4;
constexpr int AB_IN = 9216, AB_OUT = 3072, C_IN = 5168, C_INP = 5376, C_OUT = 2048;
constexpr int NUP = 2 * DFF;
constexpr float NORM_EPS = 1e-6f;
constexpr int NWAVES = 8, NTHREADS = 512;
#ifndef MK_FUSED
#define MK_FUSED 1
#endif
constexpr int N_PHASES = 1 + 13 * DEPTH;

constexpr size_t MiB = 1u << 20;
constexpr size_t WS_CTL = 0, CTL_ZERO_BYTES = 1 * MiB;
constexpr size_t SZ_W13 = (size_t)NUP * D_ * 2, SZ_W2 = (size_t)D_ * DFF * 2, SZ_ABIN = (size_t)AB_IN * D_ * 2, SZ_ABOUT = (size_t)D_ * AB_OUT * 2, SZ_CIN = (size_t)C_INP * D_ * 2, SZ_COUT = (size_t)D_ * C_OUT * 2;
constexpr size_t WS_W13 = 2 * MiB, WS_W2 = WS_W13 + 8 * SZ_W13, WS_ABIN = WS_W2 + 8 * SZ_W2, WS_ABOUT = WS_ABIN + 2 * SZ_ABIN, WS_CIN = WS_ABOUT + 2 * SZ_ABOUT, WS_COUT = WS_CIN + 2 * SZ_CIN;
constexpr size_t WS_H = WS_COUT + 2 * SZ_COUT;
constexpr size_t WS_Y = WS_H + (size_t)S_ * D_ * 2;
constexpr size_t WS_CAT = WS_Y + (size_t)S_ * D_ * 2;
constexpr size_t WS_P = WS_CAT + (size_t)S_ * AB_OUT * 2;
constexpr size_t WS_KV = WS_P + (size_t)S_ * AB_IN * 2;
constexpr size_t WS_PREV = WS_KV + (size_t)8 * 64 * 128 * 256 * 4;
constexpr size_t WS_CK = WS_PREV + (size_t)8 * 64 * 128 * 256 * 4;
constexpr size_t WS_CV = WS_CK + (size_t)4 * 512 * 128 * 4;
constexpr size_t WS_END = WS_CV + (size_t)4 * 512 * 128 * 4;
static_assert(WS_W13 % 256 == 0 && WS_W2 % 256 == 0 && WS_H % 256 == 0 && WS_P % 256 == 0 && WS_KV % 256 == 0, "alignment");

constexpr int CW_BAR = 4096;
constexpr int RING_BYTES = 131072, MISC_OFF = RING_BYTES + 320, LDS_BYTES = 147456;

#define GAS __attribute__((address_space(1)))
#define LAS __attribute__((address_space(3)))
typedef unsigned short bf16;
typedef unsigned v4u __attribute__((ext_vector_type(4)));
typedef unsigned v2u __attribute__((ext_vector_type(2)));
typedef float f32x4 __attribute__((ext_vector_type(4)));
typedef float f32x2 __attribute__((ext_vector_type(2)));
#define LDS_WAIT() asm volatile("s_waitcnt lgkmcnt(0)" ::: "memory")
__device__ __forceinline__ unsigned f2bf(float f) { unsigned u = __builtin_bit_cast(unsigned, f); return (u + 0x7fffu + ((u >> 16) & 1u)) >> 16; }
__device__ __forceinline__ unsigned pk2(float lo, float hi) { return f2bf(lo) | (f2bf(hi) << 16); }
__device__ __forceinline__ float bflo(unsigned w) { return __builtin_bit_cast(float, w << 16); }
__device__ __forceinline__ float bfhi(unsigned w) { return __builtin_bit_cast(float, w & 0xffff0000u); }
__device__ __forceinline__ float bf2f(bf16 b) { return __builtin_bit_cast(float, (unsigned)b << 16); }
__device__ __forceinline__ float wave_sum(float v) {
#pragma unroll
    for (int o = 1; o < 64; o <<= 1) v += __shfl_xor(v, o);
    return v;
}
__device__ __forceinline__ float wave_max(float v) {
#pragma unroll
    for (int o = 1; o < 64; o <<= 1) v = fmaxf(v, __shfl_xor(v, o));
    return v;
}
__device__ __forceinline__ float rdlane(float v, int j) { return __builtin_bit_cast(float, __builtin_amdgcn_readlane(__builtin_bit_cast(int, v), j)); }

#define XB_TMO      128
#define XB_XCNT(j)  (256  + 64 * (j))
#define XB_XSUB(j)  (1280 + 64 * (j))
#define XB_XGEN(j)  (2304 + 64 * (j))
#define XB_TOP      3328
#define XB_TOPGEN   3392
#define XCD_BAR_WORDS 3456
#define XB_SPIN_CAP (1u << 18)

__device__ __forceinline__ unsigned xb_ld(unsigned* p)              { return __hip_atomic_load(p, __ATOMIC_RELAXED, __HIP_MEMORY_SCOPE_AGENT); }
__device__ __forceinline__ unsigned xb_add(unsigned* p, unsigned v) { return __hip_atomic_fetch_add(p, v, __ATOMIC_RELAXED, __HIP_MEMORY_SCOPE_AGENT); }
__device__ __forceinline__ unsigned xb_xcc_id() { return (unsigned)__builtin_amdgcn_s_getreg((3 << 11) | 20) & 0xFu; }
#define XB_SPIN(cond, bar) do { unsigned _sp = 0; while (cond) { __builtin_amdgcn_s_sleep(1); \
    if ((++_sp & 255u) == 0u) { if (xb_ld(&(bar)[XB_TMO])) break; if (_sp > XB_SPIN_CAP) { atomicAdd(&(bar)[XB_TMO], 1u); break; } } } } while (0)

struct XcdBarrier {
    unsigned* bar; unsigned x;
    volatile LAS unsigned* st;
};

__device__ __forceinline__ XcdBarrier xcd_barrier_post(unsigned* bar, volatile LAS unsigned* st) {
    XcdBarrier b; b.bar = bar; b.x = xb_xcc_id(); b.st = st;
    if (threadIdx.x == 0) (void)xb_add(&bar[XB_XCNT(b.x)], 1u);
    return b;
}
__device__ __forceinline__ void xcd_barrier_complete(unsigned* bar, unsigned x, unsigned& nloc, unsigned& nx) {
    const unsigned G = gridDim.x * gridDim.y * gridDim.z;
    unsigned sum, cnt, mine, sp = 0u;
    for (;;) {
        sum = 0u; cnt = 0u; mine = 0u;
#pragma unroll
        for (unsigned j = 0; j < 16; ++j) { const unsigned c = xb_ld(&bar[XB_XCNT(j)]); sum += c; cnt += (c > 0u) ? 1u : 0u; mine = (j == x) ? c : mine; }
        if (sum == G) break;
        __builtin_amdgcn_s_sleep(1);
        if ((++sp & 255u) == 0u) { if (xb_ld(&bar[XB_TMO])) break; if (sp > XB_SPIN_CAP) { atomicAdd(&bar[XB_TMO], 1u); break; } }
    }
    nloc = mine > 0u ? mine : 1u; nx = cnt > 0u ? cnt : 1u;
}

__device__ __forceinline__ void xcd_barrier(const XcdBarrier& b) {
    asm volatile("s_waitcnt vmcnt(0)" ::: "memory");
    __syncthreads();
    if (threadIdx.x == 0) {
        unsigned* bar = b.bar;
        __builtin_amdgcn_s_waitcnt(0);
        unsigned nloc = b.st[0], nx = b.st[1];
        if (nloc == 0u) { xcd_barrier_complete(bar, b.x, nloc, nx); b.st[0] = nloc; b.st[1] = nx; }
        const unsigned old = xb_add(&bar[XB_XSUB(b.x)], 1u);
        const unsigned gen = old / nloc;
        if (old + 1u == (gen + 1u) * nloc) {
            __builtin_amdgcn_fence(__ATOMIC_RELEASE, "agent");
            asm volatile("s_waitcnt vmcnt(0)" ::: "memory");
            const unsigned og = xb_add(&bar[XB_TOP], 1u);
            const unsigned tg = og / nx;
            if (og + 1u == (tg + 1u) * nx) xb_add(&bar[XB_TOPGEN], 1u);
            else XB_SPIN(xb_ld(&bar[XB_TOPGEN]) == tg, bar);
            __builtin_amdgcn_fence(__ATOMIC_ACQUIRE, "agent");
            xb_add(&bar[XB_XGEN(b.x)], 1u);
            asm volatile("s_waitcnt vmcnt(0)" ::: "memory");
        } else {
            XB_SPIN(xb_ld(&bar[XB_XGEN(b.x)]) == gen, bar);
            __builtin_amdgcn_fence(__ATOMIC_ACQUIRE, "agent");
            asm volatile("s_waitcnt vmcnt(0)" ::: "memory");
        }
    }
    __syncthreads();
}

struct Ctx {
    const float* x; const int* pos; const float* norm_g; const float *w1, *w3, *w2, *ab_in, *ab_out, *c_in, *c_out, *ck_w1, *ck_w2, *cv_w1, *cv_w2, *pe_k, *pe_v;
    float* out; unsigned char* ws;
    int tid, lane, wave, bid, G, gw, NGW;
    LAS unsigned char* lds;
};

__device__ __forceinline__ void transpose_item(const float* W, int K, int N, bf16* WT, int dst_row0, LAS float* scr, int k0, int n0, int lane) {
#pragma unroll 8
    for (int i = 0; i < 32; ++i) { const int kk = 2 * i + (lane >> 5); const int n = n0 + (lane & 31); scr[kk * 33 + (lane & 31)] = (n < N) ? W[(size_t)(k0 + kk) * N + n] : 0.f; }
    LDS_WAIT();
    const int c = lane & 7;
#pragma unroll
    for (int j = 0; j < 4; ++j) { const int nl = (lane >> 3) + 8 * j; const LAS float* s = scr + (8 * c) * 33 + nl;
        v4u o; o.x = pk2(s[0 * 33], s[1 * 33]); o.y = pk2(s[2 * 33], s[3 * 33]); o.z = pk2(s[4 * 33], s[5 * 33]); o.w = pk2(s[6 * 33], s[7 * 33]);
        *(v4u*)(WT + (size_t)(dst_row0 + nl) * K + k0 + 8 * c) = o; }
    LDS_WAIT();
}
__device__ __forceinline__ void phase_prologue(const Ctx& c) {
    LAS float* scr = (LAS float*)(c.lds + c.wave * 16384);
    constexpr int I13 = (D_ / 64) * (DFF / 32), I2 = (DFF / 64) * (D_ / 32), IABI = (D_ / 64) * (AB_IN / 32), IABO = (AB_OUT / 64) * (D_ / 32), ICI = (D_ / 64) * (C_INP / 32), ICO = (C_OUT / 64) * (D_ / 32);
    constexpr int NFFN = 24 * I13;
    static_assert(I13 == I2, "ffn item counts");
    constexpr int NITEMS = NFFN + 2 * (IABI + IABO + ICI + ICO);
    for (int it = c.gw; it < NITEMS; it += c.NGW) {
        if (it < NFFN) {
            const int mat = it / I13, r = it % I13, lf = mat / 3, which = mat % 3;
            if (which < 2) { const int nblk = DFF / 32, kb = r / nblk, nb = r % nblk, n0 = 32 * nb;
                const float* W = (which == 0 ? c.w1 : c.w3) + (size_t)lf * D_ * DFF;
                bf16* WT = (bf16*)(c.ws + WS_W13 + (size_t)lf * SZ_W13);
                transpose_item(W, D_, DFF, WT, 256 * (n0 / 128) + (n0 % 128) + 128 * which, scr, 64 * kb, n0, c.lane);
            } else { const int nblk = D_ / 32, kb = r / nblk, nb = r % nblk;
                transpose_item(c.w2 + (size_t)lf * DFF * D_, DFF, D_, (bf16*)(c.ws + WS_W2 + (size_t)lf * SZ_W2), 32 * nb, scr, 64 * kb, 32 * nb, c.lane); }
            continue;
        }
        int r = it - NFFN;
        const int j = r / (IABI + IABO + ICI + ICO); r = r % (IABI + IABO + ICI + ICO);
        if (r < IABI) { const int nblk = AB_IN / 32, kb = r / nblk, nb = r % nblk; transpose_item(c.ab_in + (size_t)j * D_ * AB_IN, D_, AB_IN, (bf16*)(c.ws + WS_ABIN + (size_t)j * SZ_ABIN), 32 * nb, scr, 64 * kb, 32 * nb, c.lane); continue; } r -= IABI;
        if (r < IABO) { const int nblk = D_ / 32, kb = r / nblk, nb = r % nblk; transpose_item(c.ab_out + (size_t)j * AB_OUT * D_, AB_OUT, D_, (bf16*)(c.ws + WS_ABOUT + (size_t)j * SZ_ABOUT), 32 * nb, scr, 64 * kb, 32 * nb, c.lane); continue; } r -= IABO;
        if (r < ICI) { const int nblk = C_INP / 32, kb = r / nblk, nb = r % nblk; transpose_item(c.c_in + (size_t)j * D_ * C_IN, D_, C_IN, (bf16*)(c.ws + WS_CIN + (size_t)j * SZ_CIN), 32 * nb, scr, 64 * kb, 32 * nb, c.lane); continue; } r -= ICI;
        { const int nblk = D_ / 32, kb = r / nblk, nb = r % nblk; transpose_item(c.c_out + (size_t)j * C_OUT * D_, C_OUT, D_, (bf16*)(c.ws + WS_COUT + (size_t)j * SZ_COUT), 32 * nb, scr, 64 * kb, 32 * nb, c.lane); }
    }
    bf16* H = (bf16*)(c.ws + WS_H);
    for (int row = c.gw; row < S_; row += c.NGW) {
        const f32x4* xr = (const f32x4*)(c.x + (size_t)row * D_) + c.lane; f32x4* orow = (f32x4*)(c.out + (size_t)row * D_) + c.lane;
        f32x4 v[8]; float ss = 0.f;
#pragma unroll
        for (int j = 0; j < 8; ++j) { v[j] = xr[64 * j]; ss += (v[j].x * v[j].x + v[j].y * v[j].y) + (v[j].z * v[j].z + v[j].w * v[j].w); }
        const float rstd = 1.0f / sqrtf(wave_sum(ss) * (1.0f / D_) + NORM_EPS);
        v2u* h8 = (v2u*)(H + (size_t)row * D_) + c.lane;
#pragma unroll
        for (int j = 0; j < 8; ++j) { orow[64 * j] = v[j]; const f32x4 g = ((const f32x4*)c.norm_g)[c.lane + 64 * j];
            v2u o; o.x = pk2(v[j].x * rstd * g.x, v[j].y * rstd * g.y); o.y = pk2(v[j].z * rstd * g.z, v[j].w * rstd * g.w); h8[64 * j] = o; }
    }
}

__device__ __forceinline__ void phase_rowpass(const Ctx& c, const float* gpost, float coef, const float* gnext) {
    const bf16* Y = (const bf16*)(c.ws + WS_Y); bf16* H = (bf16*)(c.ws + WS_H);
    for (int row = c.gw; row < S_; row += c.NGW) {
        f32x4* xr = (f32x4*)(c.out + (size_t)row * D_) + c.lane; const v2u* yr = (const v2u*)(Y + (size_t)row * D_) + c.lane;
        f32x4 xv[8], yv[8]; float ss = 0.f;
#pragma unroll
        for (int j = 0; j < 8; ++j) { xv[j] = xr[64 * j]; const v2u w = yr[64 * j]; yv[j] = (f32x4){bflo(w.x), bfhi(w.x), bflo(w.y), bfhi(w.y)};
            ss += (yv[j].x * yv[j].x + yv[j].y * yv[j].y) + (yv[j].z * yv[j].z + yv[j].w * yv[j].w); }
        const float rstd = coef / sqrtf(wave_sum(ss) * (1.0f / D_) + NORM_EPS);
        float ss2 = 0.f;
#pragma unroll
        for (int j = 0; j < 8; ++j) { const f32x4 g = ((const f32x4*)gpost)[c.lane + 64 * j]; xv[j] = xv[j] + yv[j] * rstd * g; xr[64 * j] = xv[j];
            ss2 += (xv[j].x * xv[j].x + xv[j].y * xv[j].y) + (xv[j].z * xv[j].z + xv[j].w * xv[j].w); }
        if (gnext) {
            const float rstd2 = 1.0f / sqrtf(wave_sum(ss2) * (1.0f / D_) + NORM_EPS);
            v2u* h8 = (v2u*)(H + (size_t)row * D_) + c.lane;
#pragma unroll
            for (int j = 0; j < 8; ++j) { const f32x4 g = ((const f32x4*)gnext)[c.lane + 64 * j];
                v2u o; o.x = pk2(xv[j].x * rstd2 * g.x, xv[j].y * rstd2 * g.y); o.y = pk2(xv[j].z * rstd2 * g.z, xv[j].w * rstd2 * g.w); h8[64 * j] = o; }
        }
    }
}

__device__ __forceinline__ void sincos_ang(float ang, float& sn, float& cs) {
    double r = (double)ang * 0.15915494309189535; r -= floor(r); const float rf = (float)r;
    sn = __builtin_amdgcn_sinf(rf); cs = __builtin_amdgcn_cosf(rf);
}
__device__ __forceinline__ void rope_pair(bf16* p, int half, float sn, float cs) {
    const float x1 = bf2f(p[0]), x2 = bf2f(p[half]);
    p[0] = (bf16)f2bf(x1 * cs - x2 * sn); p[half] = (bf16)f2bf(x2 * cs + x1 * sn);
}
constexpr float LOG2_RET_BASE = 13.287712379549449f, LOG2_ROPE_THETA = 18.931568569324174f;
__device__ __forceinline__ void phase_rope_even(const Ctx& c) {
    bf16* P = (bf16*)(c.ws + WS_P);
    for (int t = c.gw; t < S_; t += c.NGW) {
        const float pos = (float)c.pos[t]; bf16* row = P + (size_t)t * AB_IN;
        { float sn, cs; sincos_ang(pos * exp2f(-(float)c.lane * (1.0f / 64.0f) * LOG2_RET_BASE), sn, cs);
#pragma unroll 4
          for (int cb = 0; cb < 16; ++cb) rope_pair(row + (cb >> 3) * 1024 + (cb & 7) * 128 + c.lane, 64, sn, cs); }
        { const int i = c.lane & 15; float sn, cs; sincos_ang(pos * exp2f(-(float)i * (1.0f / 16.0f) * LOG2_ROPE_THETA), sn, cs);
#pragma unroll
          for (int j = 0; j < 4; ++j) { const int cb = (c.lane >> 4) + 4 * j; rope_pair(row + 6144 + (cb >> 3) * 1024 + (cb & 7) * 128 + i, 16, sn, cs); } }
    }
}
__device__ __forceinline__ void phase_rope_odd(const Ctx& c) {
    bf16* P = (bf16*)(c.ws + WS_P);
    for (int t = c.gw; t < S_; t += c.NGW) {
        const float pos = (float)c.pos[t]; bf16* row = P + (size_t)t * C_INP;
        const int i = c.lane & 15; float sn, cs; sincos_ang(pos * exp2f(-(float)i * (1.0f / 16.0f) * LOG2_ROPE_THETA), sn, cs);
#pragma unroll
        for (int j = 0; j < 7; ++j) { const int cb = (c.lane >> 4) + 4 * j;
            const int col = cb < 16 ? cb * 128 : (cb < 20 ? 2048 + (cb - 16) * 128 : (cb < 24 ? 3072 + (cb - 20) * 128 : 4096 + (cb - 24) * 128));
            rope_pair(row + col + i, 16, sn, cs); }
    }
}

__device__ __forceinline__ float ret_log_gamma(int h) { return log1pf(-exp2f(-5.0f - (float)h)); }
constexpr float RET_SCALE = 0.08838834764831845f;
__device__ __forceinline__ void phase_ret_kv(const Ctx& c) {
    const bf16* P = (const bf16*)(c.ws + WS_P); float* KV = (float*)(c.ws + WS_KV);
    LAS float* Kf = (LAS float*)c.lds; LAS bf16* Vb = (LAS bf16*)(c.lds + 65536);
    for (int u = c.bid; u < 512; u += c.G) {
        const int h = u >> 6, n = u & 63; const float lg = ret_log_gamma(h);
        for (int idx = c.tid; idx < 128 * 16; idx += NTHREADS) { const int r = idx >> 4, ch = idx & 15;
            const v4u v = *(const v4u*)(P + (size_t)(128 * n + r) * AB_IN + 1024 + h * 128 + 8 * ch); const float zs = RET_SCALE * __expf(lg * (float)(127 - r));
            LAS float* d = Kf + r * 128 + 8 * ch;
            d[0] = bflo(v.x) * zs; d[1] = bfhi(v.x) * zs; d[2] = bflo(v.y) * zs; d[3] = bfhi(v.y) * zs; d[4] = bflo(v.z) * zs; d[5] = bfhi(v.z) * zs; d[6] = bflo(v.w) * zs; d[7] = bfhi(v.w) * zs; }
        for (int idx = c.tid; idx < 128 * 32; idx += NTHREADS) { const int r = idx >> 5, ch = idx & 31;
            *(LAS v4u*)(Vb + r * 256 + 8 * ch) = *(const v4u*)(P + (size_t)(128 * n + r) * AB_IN + 2048 + h * 256 + 8 * ch); }
        __syncthreads();
        const int e4 = c.tid & 63, dg = c.tid >> 6;
        f32x4 acc[16];
#pragma unroll
        for (int i = 0; i < 16; ++i) acc[i] = (f32x4){0.f, 0.f, 0.f, 0.f};
        for (int k = 0; k < 128; ++k) {
            const v2u vv = *(const LAS v2u*)(Vb + k * 256 + 4 * e4); const f32x4 v = (f32x4){bflo(vv.x), bfhi(vv.x), bflo(vv.y), bfhi(vv.y)};
#pragma unroll
            for (int i = 0; i < 16; ++i) acc[i] += v * Kf[k * 128 + dg + 8 * i];
        }
#pragma unroll
        for (int i = 0; i < 16; ++i) *(f32x4*)(KV + ((size_t)(h * 64 + n) * 128 + dg + 8 * i) * 256 + 4 * e4) = acc[i];
        __syncthreads();
    }
}
__device__ __forceinline__ void phase_ret_scan(const Ctx& c) {
    const float* KV = (const float*)(c.ws + WS_KV); float* PV = (float*)(c.ws + WS_PREV);
    for (int it = c.bid * NTHREADS + c.tid; it < 8 * 128 * 64; it += c.G * NTHREADS) {
        const int h = it >> 13, rem = it & 8191; const float cd = __expf(ret_log_gamma(h) * 128.0f);
        const size_t off = (size_t)h * 64 * 32768 + (size_t)rem * 4;
        f32x4 st = (f32x4){0.f, 0.f, 0.f, 0.f};
#pragma unroll 4
        for (int n = 0; n < 64; ++n) { const f32x4 kv = *(const f32x4*)(KV + off + (size_t)n * 32768); *(f32x4*)(PV + off + (size_t)n * 32768) = st; st = st * cd + kv; }
    }
}

struct AttnState { float m, l, o0, o1; };
__device__ __forceinline__ float dot128_bf16(const LAS float* qs, const bf16* kr) {
    float acc = 0.f;
#pragma unroll
    for (int ch = 0; ch < 16; ++ch) { const v4u kv = *(const v4u*)(kr + 8 * ch); const f32x4 qa = *(const LAS f32x4*)(qs + 8 * ch), qb = *(const LAS f32x4*)(qs + 8 * ch + 4);
        acc += qa.x * bflo(kv.x) + qa.y * bfhi(kv.x) + qa.z * bflo(kv.y) + qa.w * bfhi(kv.y) + qb.x * bflo(kv.z) + qb.y * bfhi(kv.z) + qb.z * bflo(kv.w) + qb.w * bfhi(kv.w); }
    return acc;
}
__device__ __forceinline__ float dot128_f32(const LAS float* qs, const float* kr) {
    float acc = 0.f;
#pragma unroll
    for (int ch = 0; ch < 32; ++ch) { const f32x4 kv = *(const f32x4*)(kr + 4 * ch); const f32x4 qa = *(const LAS f32x4*)(qs + 4 * ch);
        acc += qa.x * kv.x + qa.y * kv.y + qa.z * kv.z + qa.w * kv.w; }
    return acc;
}
template <class KF> __device__ __forceinline__ void attn_keys_bf16(AttnState& st, const LAS float* qs, int nkeys, const KF& kf, int lane) {
    for (int base = 0; base < nkeys; base += 64) {
        const int kidx = base + lane; const bf16 *kr = nullptr, *vr = nullptr; const bool valid = (kidx < nkeys) && kf(kidx, kr, vr);
        float s = -__builtin_inff(); if (valid) s = dot128_bf16(qs, kr);
        const float mx = wave_max(s);
        if (mx == -__builtin_inff()) continue;
        const float mn = fmaxf(st.m, mx), alpha = __builtin_amdgcn_exp2f(st.m - mn); const float p = valid ? __builtin_amdgcn_exp2f(s - mn) : 0.f;
        st.l = st.l * alpha + wave_sum(p); st.o0 *= alpha; st.o1 *= alpha; st.m = mn;
        const int cnt = (nkeys - base) < 64 ? (nkeys - base) : 64;
        for (int j = 0; j < cnt; ++j) { const float pj = rdlane(p, j); if (pj == 0.f) continue;
            const bf16 *kr2 = nullptr, *vr2 = nullptr; (void)kf(base + j, kr2, vr2);
            const unsigned vv = *(const unsigned*)(vr2 + 2 * lane); st.o0 += pj * bflo(vv); st.o1 += pj * bfhi(vv); }
    }
}
constexpr float ATT_C2 = 0.08838834764831845f * 1.4426950408889634f;

__device__ __forceinline__ void phase_ret_out_dil(const Ctx& c) {
    const bf16* P = (const bf16*)(c.ws + WS_P); const float* PV = (const float*)(c.ws + WS_PREV); bf16* CAT = (bf16*)(c.ws + WS_CAT);
    LAS float* qs = (LAS float*)(c.lds + c.wave * 1024); LAS float* sS = qs + 128;
    for (int task = c.gw; task < 16 * S_; task += c.NGW) {
        const int hh = task >> 13, t = task & (S_ - 1);
        if (hh < 8) {
            const int h = hh, n = t >> 7, q = t & 127; const float lg = ret_log_gamma(h);
            { const unsigned w = *(const unsigned*)(P + (size_t)t * AB_IN + h * 128 + 2 * c.lane); qs[2 * c.lane] = bflo(w); qs[2 * c.lane + 1] = bfhi(w); }
            LDS_WAIT();
#pragma unroll
            for (int g2 = 0; g2 < 2; ++g2) { const int k = c.lane + 64 * g2; float s = 0.f;
                if (k <= q) s = dot128_bf16(qs, P + (size_t)(128 * n + k) * AB_IN + 1024 + h * 128) * RET_SCALE * __expf(lg * (float)(q - k));
                sS[k] = s; }
            LDS_WAIT();
            f32x4 o = (f32x4){0.f, 0.f, 0.f, 0.f};
            const float* pv = PV + (size_t)(h * 64 + n) * 32768 + 4 * c.lane;
#pragma unroll 8
            for (int d = 0; d < 128; ++d) o += *(const f32x4*)(pv + d * 256) * qs[d];
            o = o * __expf(lg * (float)(q + 1));
            const bf16* vb = P + (size_t)(128 * n) * AB_IN + 2048 + h * 256 + 4 * c.lane;
            for (int k = 0; k <= q; ++k) { const v2u vv = *(const v2u*)(vb + (size_t)k * AB_IN); const float sk = sS[k];
                o += (f32x4){bflo(vv.x), bfhi(vv.x), bflo(vv.y), bfhi(vv.y)} * sk; }
            const float mean = wave_sum((o.x + o.y) + (o.z + o.w)) * (1.0f / 256.0f);
            const f32x4 dm = o - mean; const float var = wave_sum((dm.x * dm.x + dm.y * dm.y) + (dm.z * dm.z + dm.w * dm.w)) * (1.0f / 256.0f);
            const float rs = 1.0f / sqrtf(var + NORM_EPS);
            const v2u gv = *(const v2u*)(P + (size_t)t * AB_IN + 4096 + h * 256 + 4 * c.lane);
            const f32x4 g = (f32x4){bflo(gv.x), bfhi(gv.x), bflo(gv.y), bfhi(gv.y)};
            v2u ov; ov.x = pk2(g.x / (1.0f + __expf(-g.x)) * dm.x * rs, g.y / (1.0f + __expf(-g.y)) * dm.y * rs); ov.y = pk2(g.z / (1.0f + __expf(-g.z)) * dm.z * rs, g.w / (1.0f + __expf(-g.w)) * dm.w * rs);
            *(v2u*)(CAT + (size_t)t * AB_OUT + h * 256 + 4 * c.lane) = ov;
            LDS_WAIT();
        } else {
            const int h = hh - 8;
            { const unsigned w = *(const unsigned*)(P + (size_t)t * AB_IN + 6144 + h * 128 + 2 * c.lane); qs[2 * c.lane] = bflo(w) * ATT_C2; qs[2 * c.lane + 1] = bfhi(w) * ATT_C2; }
            LDS_WAIT();
            AttnState st; st.m = -__builtin_inff(); st.l = 0.f; st.o0 = 0.f; st.o1 = 0.f;
            const bf16* kb = P + 7168 + h * 128; const bf16* vb = P + 8192 + h * 128;
#pragma unroll 1
            for (int pi = 0; pi < 3; ++pi) { const int dil = pi == 0 ? 1 : (pi == 1 ? 4 : 16);
                auto kf = [=](int kidx, const bf16*& kr, const bf16*& vr) -> bool { const int tok = t - kidx * dil; const int tk = tok < 0 ? 0 : tok; kr = kb + (size_t)tk * AB_IN; vr = vb + (size_t)tk * AB_IN; return tok >= 0; };
                attn_keys_bf16(st, qs, 129, kf, c.lane); }
            const float inv = 1.0f / st.l;
            *(unsigned*)(CAT + (size_t)t * AB_OUT + 2048 + h * 128 + 2 * c.lane) = pk2(st.o0 * inv, st.o1 * inv);
            LDS_WAIT();
        }
    }
}

__device__ __forceinline__ float gelu_tanh(float x) { const float u = 0.7978845608028654f * (x + 0.044715f * x * x * x); const float t = 1.0f - 2.0f / (1.0f + __expf(2.0f * u)); return 0.5f * x * (1.0f + t); }
__device__ __forceinline__ void phase_compress(const Ctx& c, int j) {
    const bf16* P = (const bf16*)(c.ws + WS_P);
    LAS float* Xs = (LAS float*)c.lds; LAS float* PEs = (LAS float*)(c.lds + 73728); LAS float* Hs = (LAS float*)(c.lds + 90112);
    for (int u = c.bid; u < 512; u += c.G) {
        const int tensor = u >> 8, g = (u >> 6) & 3, nb = u & 63, tok0 = 128 * nb;
        const float* w1 = (tensor ? c.cv_w1 : c.ck_w1) + (size_t)j * 4096 * 256; const float* w2 = (tensor ? c.cv_w2 : c.ck_w2) + (size_t)j * 256 * 128; const float* pe = (tensor ? c.pe_v : c.pe_k) + (size_t)j * 4096;
        const int colb = (tensor ? 2560 : 2048) + g * 128;
        for (int idx = c.tid; idx < 144 * 16; idx += NTHREADS) { const int r = idx >> 4, ch = idx & 15, tok = tok0 + r;
            v4u v = (v4u){0u, 0u, 0u, 0u}; if (tok < S_) v = *(const v4u*)(P + (size_t)tok * C_INP + colb + 8 * ch);
            LAS float* d = Xs + r * 128 + 8 * ch;
            d[0] = bflo(v.x); d[1] = bfhi(v.x); d[2] = bflo(v.y); d[3] = bfhi(v.y); d[4] = bflo(v.z); d[5] = bfhi(v.z); d[6] = bflo(v.w); d[7] = bfhi(v.w); }
        for (int idx = c.tid; idx < 4096; idx += NTHREADS) PEs[idx] = pe[idx];
        __syncthreads();
        { const int jc = c.tid & 255, half = c.tid >> 8; float acc[4] = {0.f, 0.f, 0.f, 0.f};
          for (int l = 0; l < 32; ++l) {
#pragma unroll 4
            for (int d = 0; d < 128; ++d) { const float w = w1[(size_t)(l * 128 + d) * 256 + jc]; const float pv = PEs[l * 128 + d];
#pragma unroll
                for (int r = 0; r < 4; ++r) acc[r] += (Xs[(16 * (4 * half + r) + l) * 128 + d] + pv) * w; } }
#pragma unroll
          for (int r = 0; r < 4; ++r) Hs[(4 * half + r) * 256 + jc] = gelu_tanh(acc[r]); }
        __syncthreads();
        { const int r = c.tid >> 6, c2 = 2 * (c.tid & 63); float o0 = 0.f, o1 = 0.f;
#pragma unroll 4
          for (int jj = 0; jj < 256; ++jj) { const float hv = Hs[r * 256 + jj]; const f32x2 w = *(const f32x2*)(w2 + (size_t)jj * 128 + c2); o0 += hv * w.x; o1 += hv * w.y; }
          const int n = 8 * nb + r; if (n == 511) { o0 = 0.f; o1 = 0.f; }
          float* dst = (float*)(c.ws + (tensor ? WS_CV : WS_CK)) + ((size_t)(g * 512 + n) * 128 + c2);
          *(f32x2*)dst = (f32x2){o0, o1}; }
        __syncthreads();
    }
}
__device__ __forceinline__ void phase_nsa(const Ctx& c) {
    const bf16* P = (const bf16*)(c.ws + WS_P); bf16* CAT = (bf16*)(c.ws + WS_CAT);
    const float* CK = (const float*)(c.ws + WS_CK); const float* CV = (const float*)(c.ws + WS_CV);
    LAS float* qs = (LAS float*)(c.lds + c.wave * 8192); LAS float* sraw = qs + 128; LAS float* pacc = sraw + 512; LAS int* list = (LAS int*)(pacc + 512);
    const int lane = c.lane;
    for (int task = c.gw; task < 4 * S_; task += c.NGW) {
        const int g = task >> 13, t = task & (S_ - 1);
        const bf16* prow = P + (size_t)t * C_INP;
        const int ncmp = t >= 31 ? ((t - 31) >> 4) + 1 : 0;
#pragma unroll
        for (int i = 0; i < 8; ++i) pacc[lane + 64 * i] = 0.f;
        float oc[4][2];
#pragma unroll
        for (int jh = 0; jh < 4; ++jh) {
            const int h = 4 * g + jh;
            { const unsigned w = *(const unsigned*)(prow + h * 128 + 2 * lane); qs[2 * lane] = bflo(w) * ATT_C2; qs[2 * lane + 1] = bfhi(w) * ATT_C2; }
            LDS_WAIT();
            float m = -__builtin_inff(), l = 0.f, o0 = 0.f, o1 = 0.f;
            for (int base = 0; base < ncmp; base += 64) {
                const int n = base + lane; const bool valid = n < ncmp; float s = -__builtin_inff();
                if (valid) s = dot128_f32(qs, CK + (size_t)(g * 512 + n) * 128);
                sraw[n] = s;
                const float mx = wave_max(s), mn = fmaxf(m, mx), alpha = __builtin_amdgcn_exp2f(m - mn); const float p = valid ? __builtin_amdgcn_exp2f(s - mn) : 0.f;
                l = l * alpha + wave_sum(p); o0 *= alpha; o1 *= alpha; m = mn;
                const int cnt = (ncmp - base) < 64 ? (ncmp - base) : 64;
                for (int jj = 0; jj < cnt; ++jj) { const float pj = rdlane(p, jj); const f32x2 vv = *(const f32x2*)(CV + (size_t)(g * 512 + base + jj) * 128 + 2 * lane); o0 += pj * vv.x; o1 += pj * vv.y; }
            }
            LDS_WAIT();
            if (ncmp > 0) { const float inv = 1.0f / l; oc[jh][0] = o0 * inv; oc[jh][1] = o1 * inv;
                for (int n = lane; n < ncmp; n += 64) pacc[n] += __builtin_amdgcn_exp2f(sraw[n] - m) * inv; }
            else { oc[jh][0] = 0.f; oc[jh][1] = 0.f; }
            LDS_WAIT();
        }
        const int cur = t >> 6;
        float sc[2];
#pragma unroll
        for (int i = 0; i < 2; ++i) { const int mb = lane + 64 * i; float imp = 0.f;
#pragma unroll
            for (int dn = -1; dn <= 3; ++dn) { const int n = 4 * mb + dn; if (n >= 0 && n < 511) imp += pacc[n]; }
            const bool forced = (mb == 0) || (mb == cur) || (mb == cur - 1);
            sc[i] = (mb <= cur) ? imp + (forced ? 1e4f : 0.f) : -__builtin_inff(); }
        int rk0 = 0, rk1 = 0;
        for (int jj = 0; jj < 64; ++jj) { const float a = rdlane(sc[0], jj), b = rdlane(sc[1], jj);
            rk0 += (a > sc[0] || (a == sc[0] && jj < lane)) ? 1 : 0; rk0 += (b > sc[0]) ? 1 : 0;
            rk1 += (a > sc[1] || a == sc[1]) ? 1 : 0; rk1 += (b > sc[1] || (b == sc[1] && jj < lane)) ? 1 : 0; }
        const bool sel0 = (sc[0] > -__builtin_inff()) && rk0 < 16, sel1 = (sc[1] > -__builtin_inff()) && rk1 < 16;
        const unsigned long long mk0 = __ballot(sel0), mk1 = __ballot(sel1);
        const unsigned long long below = (1ull << lane) - 1ull;
        if (sel0) list[__popcll(mk0 & below)] = lane;
        if (sel1) list[__popcll(mk0) + __popcll(mk1 & below)] = lane + 64;
        const int nsel = __popcll(mk0) + __popcll(mk1);
        LDS_WAIT();
#pragma unroll 1
        for (int jh = 0; jh < 4; ++jh) {
            const int h = 4 * g + jh;
            { const unsigned w = *(const unsigned*)(prow + h * 128 + 2 * lane); qs[2 * lane] = bflo(w) * ATT_C2; qs[2 * lane + 1] = bfhi(w) * ATT_C2; }
            LDS_WAIT();
            AttnState ss; ss.m = -__builtin_inff(); ss.l = 0.f; ss.o0 = 0.f; ss.o1 = 0.f;
            { const bf16* kb = P + 3072 + g * 128; const bf16* vb = P + 3584 + g * 128;
              auto kf = [=](int kidx, const bf16*& kr, const bf16*& vr) -> bool { const int tok = 64 * list[kidx >> 6] + (kidx & 63); kr = kb + (size_t)tok * C_INP; vr = vb + (size_t)tok * C_INP; return tok <= t; };
              attn_keys_bf16(ss, qs, 64 * nsel, kf, lane); }
            AttnState sw; sw.m = -__builtin_inff(); sw.l = 0.f; sw.o0 = 0.f; sw.o1 = 0.f;
            { const bf16* kb = P + 4096 + g * 128; const bf16* vb = P + 4608 + g * 128;
              auto kf = [=](int kidx, const bf16*& kr, const bf16*& vr) -> bool { const int tok = t - kidx; const int tk = tok < 0 ? 0 : tok; kr = kb + (size_t)tk * C_INP; vr = vb + (size_t)tk * C_INP; return tok >= 0; };
              attn_keys_bf16(sw, qs, 512, kf, lane); }
            const float g0 = 1.0f / (1.0f + __expf(-bf2f(prow[5120 + 3 * h + 0]))), g1 = 1.0f / (1.0f + __expf(-bf2f(prow[5120 + 3 * h + 1]))), g2 = 1.0f / (1.0f + __expf(-bf2f(prow[5120 + 3 * h + 2])));
            const float is = 1.0f / ss.l, iw = 1.0f / sw.l;
            const float oc0 = jh == 0 ? oc[0][0] : (jh == 1 ? oc[1][0] : (jh == 2 ? oc[2][0] : oc[3][0])), oc1 = jh == 0 ? oc[0][1] : (jh == 1 ? oc[1][1] : (jh == 2 ? oc[2][1] : oc[3][1]));
            const float r0 = g0 * oc0 + g1 * ss.o0 * is + g2 * sw.o0 * iw, r1 = g0 * oc1 + g1 * ss.o1 * is + g2 * sw.o1 * iw;
            *(unsigned*)(CAT + (size_t)t * C_OUT + h * 128 + 2 * lane) = pk2(r0, r1);
            LDS_WAIT();
        }
    }
}

struct Args { const float* in[16]; float* out; unsigned char* ws; int ph_lo, ph_hi; };
__device__ __forceinline__ Ctx make_ctx(const Args& args, LAS unsigned char* lds) {
    Ctx c; c.lds = lds;
    const float* const* in = args.in;
    c.x = in[0]; c.pos = (const int*)in[1]; c.norm_g = in[2]; c.w1 = in[3]; c.w3 = in[4]; c.w2 = in[5]; c.ab_in = in[6]; c.ab_out = in[7];
    c.c_in = in[8]; c.c_out = in[9]; c.ck_w1 = in[10]; c.ck_w2 = in[11]; c.cv_w1 = in[12]; c.cv_w2 = in[13]; c.pe_k = in[14]; c.pe_v = in[15];
    float* out = args.out; unsigned char* ws = args.ws; asm volatile("" : "+s"(out), "+s"(ws));
    c.out = out; c.ws = ws;
    int tid = threadIdx.x; asm volatile("" : "+v"(tid));
    c.tid = tid; c.lane = tid & 63; c.wave = __builtin_amdgcn_readfirstlane(tid >> 6); c.bid = blockIdx.x; c.G = gridDim.x; c.gw = c.bid * NWAVES + c.wave; c.NGW = c.G * NWAVES;
    return c;
}
__global__ void __launch_bounds__(NTHREADS, 2) mk_fwd(Args args) {
    extern __shared__ __attribute__((aligned(16))) unsigned char lds_raw[];
    LAS unsigned char* const lds = (LAS unsigned char*)lds_raw;
    for (int u = threadIdx.x; u < (LDS_BYTES - RING_BYTES) / 4; u += NTHREADS) ((LAS unsigned*)(lds + RING_BYTES))[u] = 0u;
    __syncthreads();
    const int lo = args.ph_lo, hi = args.ph_hi;
#if MK_FUSED
    XcdBarrier bar = xcd_barrier_post((unsigned*)(args.ws + WS_CTL) + CW_BAR, (volatile LAS unsigned*)(lds + MISC_OFF) + 8);
#define GRID_BAR() xcd_barrier(bar)
#else
#define GRID_BAR() do { } while (0)
#endif
#define IN(k) (lo <= (k) && (k) < hi)
#define SEAM(k) do { if (IN(k) && IN((k) + 1)) GRID_BAR(); } while (0)
#define CTX() const Ctx c = make_ctx(args, lds)
#define WSP(T, off) ((T*)(c.ws + (off)))

    if (IN(0)) { CTX(); phase_prologue(c); }
    SEAM(0);
#pragma unroll 1
    for (int L = 0; L < DEPTH; ++L) {
        const int base = 1 + 13 * L, jx = L >> 1; const bool odd = (L & 1) != 0;
        if (IN(base + 0)) { CTX(); pg8::Gemm g{WSP(bf16, WS_H), (const bf16*)(c.ws + WS_W13 + (size_t)(2 * L) * SZ_W13), S_, NUP, D_}; pg8::StaticOrder So; So.init(S_, NUP, c.G, c.bid);
            pg8::EpiSwiglu E{WSP(bf16, WS_P), DFF}; pg8::gemm_phase<pg8::EpiSwiglu, pg8::StaticOrder, true, true>(c.lds, g, So, E); }
        SEAM(base + 0);
        if (IN(base + 1)) { CTX(); pg8::Gemm g{WSP(bf16, WS_P), (const bf16*)(c.ws + WS_W2 + (size_t)(2 * L) * SZ_W2), S_, D_, DFF}; pg8::StaticOrder So; So.init(S_, D_, c.G, c.bid);
            pg8::EpiStore E{WSP(bf16, WS_Y), D_}; pg8::gemm_phase<pg8::EpiStore, pg8::StaticOrder, true, true>(c.lds, g, So, E); }
        SEAM(base + 1);
        if (IN(base + 2)) { CTX(); const float* ng = c.norm_g + (size_t)L * 6 * D_; phase_rowpass(c, ng + 1 * D_, 0.5f, ng + 2 * D_); }
        SEAM(base + 2);
        if (!odd) {
            if (IN(base + 3)) { CTX(); pg8::Gemm g{WSP(bf16, WS_H), (const bf16*)(c.ws + WS_ABIN + (size_t)jx * SZ_ABIN), S_, AB_IN, D_}; pg8::StaticOrder So; So.init(S_, AB_IN, c.G, c.bid);
                pg8::EpiStore E{WSP(bf16, WS_P), AB_IN}; pg8::gemm_phase<pg8::EpiStore, pg8::StaticOrder, true, true>(c.lds, g, So, E); }
            SEAM(base + 3);
            if (IN(base + 4)) { CTX(); phase_rope_even(c); }
            SEAM(base + 4);
            if (IN(base + 5)) { CTX(); phase_ret_kv(c); }
            SEAM(base + 5);
            if (IN(base + 6)) { CTX(); phase_ret_scan(c); }
            SEAM(base + 6);
            if (IN(base + 7)) { CTX(); phase_ret_out_dil(c); }
            SEAM(base + 7);
            if (IN(base + 8)) { CTX(); pg8::Gemm g{WSP(bf16, WS_CAT), (const bf16*)(c.ws + WS_ABOUT + (size_t)jx * SZ_ABOUT), S_, D_, AB_OUT}; pg8::StaticOrder So; So.init(S_, D_, c.G, c.bid);
                pg8::EpiStore E{WSP(bf16, WS_Y), D_}; pg8::gemm_phase<pg8::EpiStore, pg8::StaticOrder, true, true>(c.lds, g, So, E); }
            SEAM(base + 8);
        } else {
            if (IN(base + 3)) { CTX(); pg8::Gemm g{WSP(bf16, WS_H), (const bf16*)(c.ws + WS_CIN + (size_t)jx * SZ_CIN), S_, C_INP, D_}; pg8::StaticOrder So; So.init(S_, C_INP, c.G, c.bid);
                pg8::EpiStore E{WSP(bf16, WS_P), C_INP}; pg8::gemm_phase<pg8::EpiStore, pg8::StaticOrder, true, true>(c.lds, g, So, E); }
            SEAM(base + 3);
            if (IN(base + 4)) { CTX(); phase_rope_odd(c); }
            SEAM(base + 4);
            if (IN(base + 5)) { CTX(); phase_compress(c, jx); }
            SEAM(base + 5);
            if (IN(base + 6)) { CTX(); phase_nsa(c); }
            SEAM(base + 6);
            SEAM(base + 7);
            if (IN(base + 8)) { CTX(); pg8::Gemm g{WSP(bf16, WS_CAT), (const bf16*)(c.ws + WS_COUT + (size_t)jx * SZ_COUT), S_, D_, C_OUT}; pg8::StaticOrder So; So.init(S_, D_, c.G, c.bid);
                pg8::EpiStore E{WSP(bf16, WS_Y), D_}; pg8::gemm_phase<pg8::EpiStore, pg8::StaticOrder, true, true>(c.lds, g, So, E); }
            SEAM(base + 8);
        }
        if (IN(base + 9)) { CTX(); const float* ng = c.norm_g + (size_t)L * 6 * D_; phase_rowpass(c, ng + 3 * D_, 1.0f, ng + 4 * D_); }
        SEAM(base + 9);
        if (IN(base + 10)) { CTX(); pg8::Gemm g{WSP(bf16, WS_H), (const bf16*)(c.ws + WS_W13 + (size_t)(2 * L + 1) * SZ_W13), S_, NUP, D_}; pg8::StaticOrder So; So.init(S_, NUP, c.G, c.bid);
            pg8::EpiSwiglu E{WSP(bf16, WS_P), DFF}; pg8::gemm_phase<pg8::EpiSwiglu, pg8::StaticOrder, true, true>(c.lds, g, So, E); }
        SEAM(base + 10);
        if (IN(base + 11)) { CTX(); pg8::Gemm g{WSP(bf16, WS_P), (const bf16*)(c.ws + WS_W2 + (size_t)(2 * L + 1) * SZ_W2), S_, D_, DFF}; pg8::StaticOrder So; So.init(S_, D_, c.G, c.bid);
            pg8::EpiStore E{WSP(bf16, WS_Y), D_}; pg8::gemm_phase<pg8::EpiStore, pg8::StaticOrder, true, true>(c.lds, g, So, E); }
        SEAM(base + 11);
        if (IN(base + 12)) { CTX(); const float* ng = c.norm_g + (size_t)L * 6 * D_; phase_rowpass(c, ng + 5 * D_, 0.5f, (L + 1 < DEPTH) ? ng + 6 * D_ : nullptr); }
        if (L + 1 < DEPTH) SEAM(base + 12);
    }
#undef IN
#undef SEAM
}

extern "C" void kernel_launch(void* const* d_in, const int* in_sizes, int n_in, void* d_out, int out_size, void* d_ws, size_t ws_size, hipStream_t stream) {
    static int grid = 0;
    if (grid == 0) {
        if (n_in != 16 || in_sizes[0] != S_ * D_ || out_size != S_ * D_ || ws_size < WS_END) { fprintf(stderr, "kernel_launch: unexpected shapes/workspace (n_in %d, in0 %d, out %d, ws %zu < %zu)\n", n_in, n_in > 0 ? in_sizes[0] : -1, out_size, ws_size, (size_t)WS_END); grid = -1; return; }
        int dev = 0, cus = 0;
        if (hipGetDevice(&dev) != hipSuccess || hipDeviceGetAttribute(&cus, hipDeviceAttributeMultiprocessorCount, dev) != hipSuccess) { grid = -1; return; }
        if (hipFuncSetAttribute((const void*)mk_fwd, hipFuncAttributeMaxDynamicSharedMemorySize, LDS_BYTES) != hipSuccess) { fprintf(stderr, "kernel_launch: hipFuncSetAttribute failed\n"); grid = -1; return; }
        int per_cu = 0;
        if (hipOccupancyMaxActiveBlocksPerMultiprocessor(&per_cu, (const void*)mk_fwd, NTHREADS, LDS_BYTES) != hipSuccess || per_cu < 1) fprintf(stderr, "kernel_launch: occupancy query says %d\n", per_cu);
        (void)hipGetLastError();
        grid = cus;
    }
    if (grid < 0) return;
    (void)hipMemsetAsync((char*)d_ws + WS_CTL, 0, CTL_ZERO_BYTES, stream);
    Args a{};
    for (int i = 0; i < 16; ++i) a.in[i] = (const float*)d_in[i];
    a.out = (float*)d_out; a.ws = (unsigned char*)d_ws;
#if MK_FUSED
    a.ph_lo = 0; a.ph_hi = N_PHASES;
    hipLaunchKernelGGL(mk_fwd, dim3(grid), dim3(NTHREADS), LDS_BYTES, stream, a);
#else
    for (int p = 0; p < N_PHASES; ++p) {
        if (p > 0 && (((p - 1) / 13) & 1) && ((p - 1) % 13) == 7) continue;
        a.ph_lo = p; a.ph_hi = p + 1;
        hipLaunchKernelGGL(mk_fwd, dim3(grid), dim3(NTHREADS), LDS_BYTES, stream, a);
    }
#endif
}
```

```cpp
#include <hip/hip_runtime.h>
#include <cstdio>
#include <cstdint>
namespace pg8 {
#define PG8_LAS __attribute__((address_space(3)))
typedef unsigned short bf16_t;
typedef short bf16x8 __attribute__((ext_vector_type(8)));
typedef float f32x4 __attribute__((ext_vector_type(4)));
typedef unsigned u32x4 __attribute__((ext_vector_type(4)));
constexpr int BM = 256, BK = 64, HALF = 128, HTB = HALF * BK * 2  , STAGE_BYTES = 8 * HTB, NXCD = 8, WGM = 8;

__host__ __device__ __forceinline__ int lds_byte(int r, int c) { const int st = (r >> 4) * 2 + (c >> 5), rr = r & 15, cc = c & 31, ob = rr * 64 + cc * 2; return st * 1024 + (ob ^ (((ob >> 9) & 1) << 5)); }
__host__ __device__ __forceinline__ void stage_rc(int b, int& R, int& C) { const int st = b / 1024, sb = b % 1024, swz = sb ^ (((sb >> 9) & 1) << 5); R = (st >> 1) * 16 + swz / 64; C = (st & 1) * 32 + (swz % 64) / 2; }
__host__ __device__ __forceinline__ int perm32(int rho) { const int n = rho >> 4, i = rho & 15; return 8 * (i >> 2) + 4 * n + (i & 3); }

struct Unit { int pm, pn; };
struct Gemm { const bf16_t* A; const bf16_t* Bt; int M, N, K; };

struct StaticOrder {
    int nM, nN, nwg, G, c;
    __host__ __device__ void init(int M, int N, int G_, int c_) { nM = M / BM; nN = N / BM; nwg = nM * nN; G = G_; c = c_; }
    __host__ __device__ bool next(int i, Unit& u) const {
        const long L = (long)i * G + c; if (L >= nwg) return false;
        int wgid = (int)L; { const int q = nwg / NXCD, r = nwg % NXCD, xcd = wgid % NXCD, off = wgid / NXCD; wgid = (xcd < r ? xcd * (q + 1) : r * (q + 1) + (xcd - r) * q) + off; }
        const int nig = WGM * nN, gid = wgid / nig, fm = gid * WGM, gsz = (nM - fm) < WGM ? (nM - fm) : WGM;
        u.pm = fm + ((wgid % nig) % gsz); u.pn = (wgid % nig) / gsz; return true;
    }
    __device__ __forceinline__ void a_ready(const Unit&) const {}
    __device__ __forceinline__ void done(const Unit&) const {}
};

__device__ __forceinline__ unsigned cvt_pk_bf16(float lo, float hi) { unsigned r; asm volatile("v_cvt_pk_bf16_f32 %0, %1, %2" : "=v"(r) : "v"(lo), "v"(hi)); return r; }
struct EpiStore {
    static constexpr bool PERM = true, AFTER_DRAIN = false;
    bf16_t* O; int ldc;
    __device__ __forceinline__ void operator()(const f32x4 (&acc)[2][2][4][2], const Unit& u, int wr, int wc, int fr, int fq) const {
        const int row0 = u.pm * BM + wr * 64 + fr, col0 = u.pn * BM + wc * 32 + 8 * fq;
#pragma unroll
        for (int ai = 0; ai < 2; ++ai)
#pragma unroll
            for (int m = 0; m < 4; ++m) { bf16_t* rowp = O + (size_t)(row0 + ai * HALF + m * 16) * ldc + col0;
#pragma unroll
                for (int bj = 0; bj < 2; ++bj) { const f32x4 v0 = acc[ai][bj][m][0], v1 = acc[ai][bj][m][1];
                    u32x4 w; w.x = cvt_pk_bf16(v0[0], v0[1]); w.y = cvt_pk_bf16(v0[2], v0[3]); w.z = cvt_pk_bf16(v1[0], v1[1]); w.w = cvt_pk_bf16(v1[2], v1[3]);
                    *(u32x4*)(rowp + bj * HALF) = w; } }
    }
};
__device__ __forceinline__ float silu_f(float a) { return a * __builtin_amdgcn_rcpf(1.0f + __expf(-a)); }
struct EpiSwiglu {
    static constexpr bool PERM = true, AFTER_DRAIN = false;
    bf16_t* O; int ldc;
    __device__ __forceinline__ void operator()(const f32x4 (&acc)[2][2][4][2], const Unit& u, int wr, int wc, int fr, int fq) const {
        const int row0 = u.pm * BM + wr * 64 + fr, col0 = u.pn * HALF + wc * 32 + 8 * fq;
#pragma unroll
        for (int ai = 0; ai < 2; ++ai)
#pragma unroll
            for (int m = 0; m < 4; ++m) { bf16_t* rowp = O + (size_t)(row0 + ai * HALF + m * 16) * ldc + col0;
                const f32x4 a0 = acc[ai][0][m][0], a1 = acc[ai][0][m][1], b0 = acc[ai][1][m][0], b1 = acc[ai][1][m][1];
                u32x4 w; w.x = cvt_pk_bf16(silu_f(a0[0]) * b0[0], silu_f(a0[1]) * b0[1]); w.y = cvt_pk_bf16(silu_f(a0[2]) * b0[2], silu_f(a0[3]) * b0[3]);
                w.z = cvt_pk_bf16(silu_f(a1[0]) * b1[0], silu_f(a1[1]) * b1[1]); w.w = cvt_pk_bf16(silu_f(a1[2]) * b1[2], silu_f(a1[3]) * b1[3]);
                *(u32x4*)rowp = w; }
    }
};

template <class Epi, class Sched, bool ALIGN_EPI = false, bool SP2 = false>
__device__ __forceinline__ void gemm_phase(PG8_LAS unsigned char* lds, const Gemm g, const Sched& S, const Epi& E, int tid_in) {
    int tid_l = tid_in; asm volatile("" : "+v"(tid_l));
    const int tid = tid_l, wid = __builtin_amdgcn_readfirstlane(tid >> 6), lane = tid & 63, wr = wid >> 2, wc = wid & 3, fr = lane & 15, fq = lane >> 4;
    const int K = g.K, nt = K / BK;
    unsigned voffA[2], voffB[2];
#pragma unroll
    for (int i = 0; i < 2; ++i) { int R, C; stage_rc(tid * 16 + i * 8192, R, C); const int Rb = Epi::PERM ? ((R & ~31) + perm32(R & 31)) : R;
        voffA[i] = (unsigned)(R * K + C) * 2u; voffB[i] = (unsigned)(Rb * K + C) * 2u; }
    const size_t kstep = (size_t)(BK * 2);
    const size_t hstep = (size_t)HALF * K * 2;
    const size_t tstep = 2 * hstep;
    const unsigned ldsw = (unsigned)wid * 1024u;
    const int aoff = lds_byte(wr * 64 + fr, fq * 8), boff = lds_byte(wc * 32 + fr, fq * 8);
#define PG8_SA(b, h) (((b) * 2 + (h)) * HTB)
#define PG8_SB(b, h) ((4 + (b) * 2 + (h)) * HTB)
#define PG8_STAGE(bufoff, gbase, voff) do { _Pragma("unroll") for (int _i = 0; _i < 2; ++_i) \
        __builtin_amdgcn_global_load_lds((const unsigned*)((const char*)(gbase) + (voff)[_i]), (PG8_LAS unsigned*)(lds + (bufoff) + ldsw + _i * 8192), 16, 0, 0); } while (0)
#define PG8_LDA(dst, b, h) do { _Pragma("unroll") for (int m = 0; m < 4; ++m) _Pragma("unroll") for (int k = 0; k < 2; ++k) dst[m][k] = *(const PG8_LAS bf16x8*)(lds + PG8_SA(b, h) + aoff + m * 2048 + k * 1024); } while (0)
#define PG8_LDB(dst, b, h) do { _Pragma("unroll") for (int n = 0; n < 2; ++n) _Pragma("unroll") for (int k = 0; k < 2; ++k) dst[n][k] = *(const PG8_LAS bf16x8*)(lds + PG8_SB(b, h) + boff + n * 2048 + k * 1024); } while (0)
#define PG8_MMA(ai, bj, At, Bt) do { __builtin_amdgcn_s_setprio(1); _Pragma("unroll") for (int m = 0; m < 4; ++m) _Pragma("unroll") for (int n = 0; n < 2; ++n) _Pragma("unroll") for (int k = 0; k < 2; ++k) \
        acc[ai][bj][m][n] = __builtin_amdgcn_mfma_f32_16x16x32_bf16(Bt[n][k], At[m][k], acc[ai][bj][m][n], 0, 0, 0); __builtin_amdgcn_s_setprio(0); } while (0)
#define PG8_WAIT_V(n) asm volatile("s_waitcnt vmcnt(" #n ")" ::: "memory")
#define PG8_WAIT_L(n) asm volatile("s_waitcnt lgkmcnt(" #n ")" ::: "memory")
#define PG8_BAR __builtin_amdgcn_s_barrier()
#define PG8_SCHED __builtin_amdgcn_sched_barrier(0)
    Unit cur, nxt; int ui = 0;
    if (!S.next(0, cur)) return;
    f32x4 acc[2][2][4][2];
#pragma unroll
    for (int a = 0; a < 2; ++a)
#pragma unroll
        for (int b = 0; b < 2; ++b)
#pragma unroll
            for (int m = 0; m < 4; ++m)
#pragma unroll
                for (int n = 0; n < 2; ++n) acc[a][b][m][n] = (f32x4){0.f, 0.f, 0.f, 0.f};
    bf16x8 At[4][2], B0[2][2], B1[2][2];
    const char* cA = (const char*)g.A + (size_t)cur.pm * tstep; const char* cB = (const char*)g.Bt + (size_t)cur.pn * tstep;
    S.a_ready(cur);
    if constexpr (SP2) {
        PG8_STAGE(PG8_SB(0, 0), cB, voffB); PG8_STAGE(PG8_SB(0, 1), cB + hstep, voffB); PG8_STAGE(PG8_SA(0, 0), cA, voffA); PG8_STAGE(PG8_SA(0, 1), cA + hstep, voffA);
        if (wr == 1) PG8_BAR;
        PG8_WAIT_V(2); PG8_BAR;
        PG8_STAGE(PG8_SB(1, 0), cB + kstep, voffB); PG8_STAGE(PG8_SA(1, 0), cA + kstep, voffA); PG8_STAGE(PG8_SB(1, 1), cB + hstep + kstep, voffB);
        PG8_WAIT_V(6); PG8_BAR;
    } else {
        PG8_STAGE(PG8_SB(0, 0), cB, voffB); PG8_STAGE(PG8_SA(0, 0), cA, voffA); PG8_STAGE(PG8_SB(0, 1), cB + hstep, voffB); PG8_STAGE(PG8_SA(0, 1), cA + hstep, voffA);
        if (wr == 1) PG8_BAR;
        PG8_WAIT_V(4); PG8_BAR;
        PG8_STAGE(PG8_SB(1, 0), cB + kstep, voffB); PG8_STAGE(PG8_SA(1, 0), cA + kstep, voffA); PG8_STAGE(PG8_SB(1, 1), cB + hstep + kstep, voffB);
        PG8_WAIT_V(6); PG8_BAR;
    }
    for (;;) {
        const bool has_next = S.next(ui + 1, nxt);
        const char* nA = has_next ? (const char*)g.A + (size_t)nxt.pm * tstep : cA; const char* nB = has_next ? (const char*)g.Bt + (size_t)nxt.pn * tstep : cB;
        for (int t = 0; t < nt; t += 2) {
            const bool last = (t == nt - 2);
            const char* a1 = cA + (size_t)(t + 1) * kstep;
            const char* a2 = last ? nA : cA + (size_t)(t + 2) * kstep; const char* b2 = last ? nB : cB + (size_t)(t + 2) * kstep;
            const char* a3 = a2 + kstep; const char* b3 = b2 + kstep;
            if (last && has_next) S.a_ready(nxt);
            if constexpr (SP2) {
            PG8_LDB(B0, 0, 0); PG8_LDB(B1, 0, 1); PG8_SCHED; PG8_LDA(At, 0, 0); PG8_STAGE(PG8_SA(1, 1), a1 + hstep, voffA);
            PG8_WAIT_V(8); PG8_WAIT_L(0); PG8_BAR; PG8_MMA(0, 0, At, B0); PG8_MMA(0, 1, At, B1); PG8_BAR; PG8_SCHED;
            PG8_LDA(At, 0, 1); PG8_STAGE(PG8_SB(0, 0), b2, voffB); PG8_STAGE(PG8_SB(0, 1), b2 + hstep, voffB); PG8_STAGE(PG8_SA(0, 0), a2, voffA);
            PG8_WAIT_V(8); PG8_WAIT_L(0); PG8_BAR; PG8_MMA(1, 0, At, B0); PG8_MMA(1, 1, At, B1); PG8_BAR; PG8_SCHED;
            PG8_LDB(B0, 1, 0); PG8_LDB(B1, 1, 1); PG8_SCHED; PG8_LDA(At, 1, 0); PG8_STAGE(PG8_SA(0, 1), a2 + hstep, voffA);
            PG8_WAIT_V(8); PG8_WAIT_L(0); PG8_BAR; PG8_MMA(0, 0, At, B0); PG8_MMA(0, 1, At, B1); PG8_BAR; PG8_SCHED;
            PG8_LDA(At, 1, 1); PG8_STAGE(PG8_SB(1, 0), b3, voffB); PG8_STAGE(PG8_SB(1, 1), b3 + hstep, voffB); PG8_STAGE(PG8_SA(1, 0), a3, voffA);
            PG8_WAIT_V(8); PG8_WAIT_L(0); PG8_BAR; PG8_MMA(1, 0, At, B0); PG8_MMA(1, 1, At, B1); PG8_BAR; PG8_SCHED;
            } else {
            PG8_LDB(B0, 0, 0); PG8_SCHED; PG8_LDA(At, 0, 0); PG8_STAGE(PG8_SA(1, 1), a1 + hstep, voffA);
            PG8_WAIT_L(8); PG8_BAR; PG8_WAIT_L(0); PG8_MMA(0, 0, At, B0); PG8_BAR; PG8_SCHED;
            PG8_LDB(B1, 0, 1); PG8_STAGE(PG8_SB(0, 0), b2, voffB);
            PG8_BAR; PG8_WAIT_L(0); PG8_MMA(0, 1, At, B1); PG8_BAR;
            PG8_LDA(At, 0, 1); PG8_STAGE(PG8_SA(0, 0), a2, voffA);
            PG8_BAR; PG8_WAIT_L(0); PG8_MMA(1, 0, At, B0); PG8_BAR; PG8_SCHED;
            PG8_STAGE(PG8_SB(0, 1), b2 + hstep, voffB);
            PG8_WAIT_V(6); PG8_BAR; PG8_MMA(1, 1, At, B1); PG8_BAR;
            PG8_LDB(B0, 1, 0); PG8_SCHED; PG8_LDA(At, 1, 0); PG8_STAGE(PG8_SA(0, 1), a2 + hstep, voffA);
            PG8_WAIT_L(8); PG8_BAR; PG8_WAIT_L(0); PG8_MMA(0, 0, At, B0); PG8_BAR; PG8_SCHED;
            PG8_LDB(B1, 1, 1); PG8_STAGE(PG8_SB(1, 0), b3, voffB);
            PG8_BAR; PG8_WAIT_L(0); PG8_MMA(0, 1, At, B1); PG8_BAR;
            PG8_LDA(At, 1, 1); PG8_STAGE(PG8_SA(1, 0), a3, voffA);
            PG8_BAR; PG8_WAIT_L(0); PG8_MMA(1, 0, At, B0); PG8_BAR; PG8_SCHED;
            PG8_STAGE(PG8_SB(1, 1), b3 + hstep, voffB);
            PG8_WAIT_V(6); PG8_BAR; PG8_MMA(1, 1, At, B1); PG8_BAR;
            }
        }
        if constexpr (ALIGN_EPI) { if (wr == 0) PG8_BAR; }
        if constexpr (!Epi::AFTER_DRAIN) { E(acc, cur, wr, wc, fr, fq); S.done(cur); }
        if (!has_next) break;
#pragma unroll
        for (int a = 0; a < 2; ++a)
#pragma unroll
            for (int b = 0; b < 2; ++b)
#pragma unroll
                for (int m = 0; m < 4; ++m)
#pragma unroll
                    for (int n = 0; n < 2; ++n) acc[a][b][m][n] = (f32x4){0.f, 0.f, 0.f, 0.f};
        cur = nxt; cA = nA; cB = nB; ++ui;
        if constexpr (ALIGN_EPI) { if (wr == 1) PG8_BAR; }
    }
    PG8_WAIT_V(0);
    if constexpr (!ALIGN_EPI) { if (wr == 0) PG8_BAR; }
    PG8_BAR;
    if constexpr (Epi::AFTER_DRAIN) { E.fused(acc, cur, wr, wc, fr, fq, lds, wid, lane); S.done(cur); }
#undef PG8_SA
#undef PG8_SB
#undef PG8_STAGE
#undef PG8_LDA
#undef PG8_LDB
#undef PG8_MMA
#undef PG8_WAIT_V
#undef PG8_WAIT_L
#undef PG8_BAR
#undef PG8_SCHED
}
}

constexpr int S_ = 8192, D_ = 2048, DFF = 5504, DEPTH = 4;
constexpr int AB_IN = 9216, AB_OUT = 3072, C_IN = 5168, C_INP = 5376, C_OUT = 2048;
constexpr int NUP = 2 * DFF;
constexpr float NORM_EPS = 1e-6f;
constexpr int NWAVES = 8, NTHREADS = 512;
#ifndef MK_FUSED
#define MK_FUSED 1
#endif
constexpr int N_PHASES = 1 + 13 * DEPTH;

constexpr size_t MiB = 1u << 20;
constexpr size_t WS_CTL = 0, CTL_ZERO_BYTES = 1 * MiB;
constexpr size_t SZ_W13 = (size_t)NUP * D_ * 2, SZ_W2 = (size_t)D_ * DFF * 2, SZ_ABIN = (size_t)AB_IN * D_ * 2, SZ_ABOUT = (size_t)D_ * AB_OUT * 2, SZ_CIN = (size_t)C_INP * D_ * 2, SZ_COUT = (size_t)D_ * C_OUT * 2;
constexpr size_t WS_W13 = 2 * MiB, WS_W2 = WS_W13 + 8 * SZ_W13, WS_ABIN = WS_W2 + 8 * SZ_W2, WS_ABOUT = WS_ABIN + 2 * SZ_ABIN, WS_CIN = WS_ABOUT + 2 * SZ_ABOUT, WS_COUT = WS_CIN + 2 * SZ_CIN;
constexpr size_t WS_H = WS_COUT + 2 * SZ_COUT;
constexpr size_t WS_Y = WS_H + (size_t)S_ * D_ * 2;
constexpr size_t WS_CAT = WS_Y + (size_t)S_ * D_ * 2;
constexpr size_t WS_P = WS_CAT + (size_t)S_ * AB_OUT * 2;
constexpr size_t WS_KV = WS_P + (size_t)S_ * AB_IN * 2;
constexpr size_t WS_PREV = WS_KV + (size_t)8 * 64 * 128 * 256 * 4;
constexpr size_t WS_CK = WS_PREV + (size_t)8 * 64 * 128 * 256 * 4;
constexpr size_t WS_CV = WS_CK + (size_t)4 * 512 * 128 * 4;
constexpr size_t WS_OACC = WS_CV + (size_t)4 * 512 * 128 * 4;
constexpr size_t WS_BM = WS_OACC + (size_t)S_ * C_OUT * 2;
constexpr size_t WS_END = WS_BM + (size_t)4 * S_ * 4 * 4;
static_assert(WS_W13 % 256 == 0 && WS_W2 % 256 == 0 && WS_H % 256 == 0 && WS_P % 256 == 0 && WS_KV % 256 == 0, "alignment");

constexpr int CW_BAR = 4096;
constexpr int RING_BYTES = 131072, MISC_OFF = RING_BYTES + 320, LDS_BYTES = 147456;

#define GAS __attribute__((address_space(1)))
#define LAS __attribute__((address_space(3)))
typedef unsigned short bf16;
typedef unsigned v4u __attribute__((ext_vector_type(4)));
typedef unsigned v2u __attribute__((ext_vector_type(2)));
typedef float f32x4 __attribute__((ext_vector_type(4)));
typedef float f32x2 __attribute__((ext_vector_type(2)));
#define LDS_WAIT() asm volatile("s_waitcnt lgkmcnt(0)" ::: "memory")
__device__ __forceinline__ unsigned f2bf(float f) { unsigned u = __builtin_bit_cast(unsigned, f); return (u + 0x7fffu + ((u >> 16) & 1u)) >> 16; }
__device__ __forceinline__ unsigned pk2(float lo, float hi) { return f2bf(lo) | (f2bf(hi) << 16); }
__device__ __forceinline__ float bflo(unsigned w) { return __builtin_bit_cast(float, w << 16); }
__device__ __forceinline__ float bfhi(unsigned w) { return __builtin_bit_cast(float, w & 0xffff0000u); }
__device__ __forceinline__ float bf2f(bf16 b) { return __builtin_bit_cast(float, (unsigned)b << 16); }
__device__ __forceinline__ float wave_sum(float v) {
#pragma unroll
    for (int o = 1; o < 64; o <<= 1) v += __shfl_xor(v, o);
    return v;
}
__device__ __forceinline__ float wave_max(float v) {
#pragma unroll
    for (int o = 1; o < 64; o <<= 1) v = fmaxf(v, __shfl_xor(v, o));
    return v;
}
__device__ __forceinline__ float rdlane(float v, int j) { return __builtin_bit_cast(float, __builtin_amdgcn_readlane(__builtin_bit_cast(int, v), j)); }

#define XB_TMO      128
#define XB_XCNT(j)  (256  + 64 * (j))
#define XB_XSUB(j)  (1280 + 64 * (j))
#define XB_XGEN(j)  (2304 + 64 * (j))
#define XB_TOP      3328
#define XB_TOPGEN   3392
#define XCD_BAR_WORDS 3456
#define XB_SPIN_CAP (1u << 18)

__device__ __forceinline__ unsigned xb_ld(unsigned* p)              { return __hip_atomic_load(p, __ATOMIC_RELAXED, __HIP_MEMORY_SCOPE_AGENT); }
__device__ __forceinline__ unsigned xb_add(unsigned* p, unsigned v) { return __hip_atomic_fetch_add(p, v, __ATOMIC_RELAXED, __HIP_MEMORY_SCOPE_AGENT); }
__device__ __forceinline__ unsigned xb_xcc_id() { return (unsigned)__builtin_amdgcn_s_getreg((3 << 11) | 20) & 0xFu; }
#define XB_SPIN(cond, bar) do { unsigned _sp = 0; while (cond) { __builtin_amdgcn_s_sleep(1); \
    if ((++_sp & 255u) == 0u) { if (xb_ld(&(bar)[XB_TMO])) break; if (_sp > XB_SPIN_CAP) { atomicAdd(&(bar)[XB_TMO], 1u); break; } } } } while (0)

struct XcdBarrier {
    unsigned* bar; unsigned x;
    volatile LAS unsigned* st;
};

__device__ __forceinline__ XcdBarrier xcd_barrier_post(unsigned* bar, volatile LAS unsigned* st) {
    XcdBarrier b; b.bar = bar; b.x = xb_xcc_id(); b.st = st;
    if (threadIdx.x == 0) (void)xb_add(&bar[XB_XCNT(b.x)], 1u);
    return b;
}
__device__ __forceinline__ void xcd_barrier_complete(unsigned* bar, unsigned x, unsigned& nloc, unsigned& nx) {
    const unsigned G = gridDim.x * gridDim.y * gridDim.z;
    unsigned sum, cnt, mine, sp = 0u;
    for (;;) {
        sum = 0u; cnt = 0u; mine = 0u;
#pragma unroll
        for (unsigned j = 0; j < 16; ++j) { const unsigned c = xb_ld(&bar[XB_XCNT(j)]); sum += c; cnt += (c > 0u) ? 1u : 0u; mine = (j == x) ? c : mine; }
        if (sum == G) break;
        __builtin_amdgcn_s_sleep(1);
        if ((++sp & 255u) == 0u) { if (xb_ld(&bar[XB_TMO])) break; if (sp > XB_SPIN_CAP) { atomicAdd(&bar[XB_TMO], 1u); break; } }
    }
    nloc = mine > 0u ? mine : 1u; nx = cnt > 0u ? cnt : 1u;
}

__device__ __forceinline__ void xcd_barrier(const XcdBarrier& b) {
    asm volatile("s_waitcnt vmcnt(0)" ::: "memory");
    __syncthreads();
    if (threadIdx.x == 0) {
        unsigned* bar = b.bar;
        __builtin_amdgcn_s_waitcnt(0);
        unsigned nloc = b.st[0], nx = b.st[1];
        if (nloc == 0u) { xcd_barrier_complete(bar, b.x, nloc, nx); b.st[0] = nloc; b.st[1] = nx; }
        const unsigned old = xb_add(&bar[XB_XSUB(b.x)], 1u);
        const unsigned gen = old / nloc;
        if (old + 1u == (gen + 1u) * nloc) {
            __builtin_amdgcn_fence(__ATOMIC_RELEASE, "agent");
            asm volatile("s_waitcnt vmcnt(0)" ::: "memory");
            const unsigned og = xb_add(&bar[XB_TOP], 1u);
            const unsigned tg = og / nx;
            if (og + 1u == (tg + 1u) * nx) xb_add(&bar[XB_TOPGEN], 1u);
            else XB_SPIN(xb_ld(&bar[XB_TOPGEN]) == tg, bar);
            __builtin_amdgcn_fence(__ATOMIC_ACQUIRE, "agent");
            xb_add(&bar[XB_XGEN(b.x)], 1u);
            asm volatile("s_waitcnt vmcnt(0)" ::: "memory");
        } else {
            XB_SPIN(xb_ld(&bar[XB_XGEN(b.x)]) == gen, bar);
            __builtin_amdgcn_fence(__ATOMIC_ACQUIRE, "agent");
            asm volatile("s_waitcnt vmcnt(0)" ::: "memory");
        }
    }
    __syncthreads();
}

struct Ctx {
    const float* x; const int* pos; const float* norm_g; const float *w1, *w3, *w2, *ab_in, *ab_out, *c_in, *c_out, *ck_w1, *ck_w2, *cv_w1, *cv_w2, *pe_k, *pe_v;
    float* out; unsigned char* ws;
    int tid, lane, wave, bid, G, gw, NGW;
    LAS unsigned char* lds;
};

__device__ __forceinline__ void transpose_item(const float* W, int K, int N, bf16* WT, int dst_row0, LAS float* scr, int k0, int n0, int lane) {
#pragma unroll 8
    for (int i = 0; i < 32; ++i) { const int kk = 2 * i + (lane >> 5); const int n = n0 + (lane & 31); scr[kk * 33 + (lane & 31)] = (n < N) ? W[(size_t)(k0 + kk) * N + n] : 0.f; }
    LDS_WAIT();
    const int c = lane & 7;
#pragma unroll
    for (int j = 0; j < 4; ++j) { const int nl = (lane >> 3) + 8 * j; const LAS float* s = scr + (8 * c) * 33 + nl;
        v4u o; o.x = pk2(s[0 * 33], s[1 * 33]); o.y = pk2(s[2 * 33], s[3 * 33]); o.z = pk2(s[4 * 33], s[5 * 33]); o.w = pk2(s[6 * 33], s[7 * 33]);
        *(v4u*)(WT + (size_t)(dst_row0 + nl) * K + k0 + 8 * c) = o; }
    LDS_WAIT();
}
__device__ __forceinline__ void phase_prologue(const Ctx& c) {
    LAS float* scr = (LAS float*)(c.lds + c.wave * 16384);
    constexpr int I13 = (D_ / 64) * (DFF / 32), I2 = (DFF / 64) * (D_ / 32), IABI = (D_ / 64) * (AB_IN / 32), IABO = (AB_OUT / 64) * (D_ / 32), ICI = (D_ / 64) * (C_INP / 32), ICO = (C_OUT / 64) * (D_ / 32);
    constexpr int NFFN = 24 * I13;
    static_assert(I13 == I2, "ffn item counts");
    constexpr int NITEMS = NFFN + 2 * (IABI + IABO + ICI + ICO);
    for (int it = c.gw; it < NITEMS; it += c.NGW) {
        if (it < NFFN) {
            const int mat = it / I13, r = it % I13, lf = mat / 3, which = mat % 3;
            if (which < 2) { const int nblk = DFF / 32, kb = r / nblk, nb = r % nblk, n0 = 32 * nb;
                const float* W = (which == 0 ? c.w1 : c.w3) + (size_t)lf * D_ * DFF;
                bf16* WT = (bf16*)(c.ws + WS_W13 + (size_t)lf * SZ_W13);
                transpose_item(W, D_, DFF, WT, 256 * (n0 / 128) + (n0 % 128) + 128 * which, scr, 64 * kb, n0, c.lane);
            } else { const int nblk = D_ / 32, kb = r / nblk, nb = r % nblk;
                transpose_item(c.w2 + (size_t)lf * DFF * D_, DFF, D_, (bf16*)(c.ws + WS_W2 + (size_t)lf * SZ_W2), 32 * nb, scr, 64 * kb, 32 * nb, c.lane); }
            continue;
        }
        int r = it - NFFN;
        const int j = r / (IABI + IABO + ICI + ICO); r = r % (IABI + IABO + ICI + ICO);
        if (r < IABI) { const int nblk = AB_IN / 32, kb = r / nblk, nb = r % nblk; transpose_item(c.ab_in + (size_t)j * D_ * AB_IN, D_, AB_IN, (bf16*)(c.ws + WS_ABIN + (size_t)j * SZ_ABIN), 32 * nb, scr, 64 * kb, 32 * nb, c.lane); continue; } r -= IABI;
        if (r < IABO) { const int nblk = D_ / 32, kb = r / nblk, nb = r % nblk; transpose_item(c.ab_out + (size_t)j * AB_OUT * D_, AB_OUT, D_, (bf16*)(c.ws + WS_ABOUT + (size_t)j * SZ_ABOUT), 32 * nb, scr, 64 * kb, 32 * nb, c.lane); continue; } r -= IABO;
        if (r < ICI) { const int nblk = C_INP / 32, kb = r / nblk, nb = r % nblk; transpose_item(c.c_in + (size_t)j * D_ * C_IN, D_, C_IN, (bf16*)(c.ws + WS_CIN + (size_t)j * SZ_CIN), 32 * nb, scr, 64 * kb, 32 * nb, c.lane); continue; } r -= ICI;
        { const int nblk = D_ / 32, kb = r / nblk, nb = r % nblk; transpose_item(c.c_out + (size_t)j * C_OUT * D_, C_OUT, D_, (bf16*)(c.ws + WS_COUT + (size_t)j * SZ_COUT), 32 * nb, scr, 64 * kb, 32 * nb, c.lane); }
    }
    bf16* H = (bf16*)(c.ws + WS_H);
    for (int row = c.gw; row < S_; row += c.NGW) {
        const f32x4* xr = (const f32x4*)(c.x + (size_t)row * D_) + c.lane; f32x4* orow = (f32x4*)(c.out + (size_t)row * D_) + c.lane;
        f32x4 v[8]; float ss = 0.f;
#pragma unroll
        for (int j = 0; j < 8; ++j) { v[j] = xr[64 * j]; ss += (v[j].x * v[j].x + v[j].y * v[j].y) + (v[j].z * v[j].z + v[j].w * v[j].w); }
        const float rstd = 1.0f / sqrtf(wave_sum(ss) * (1.0f / D_) + NORM_EPS);
        v2u* h8 = (v2u*)(H + (size_t)row * D_) + c.lane;
#pragma unroll
        for (int j = 0; j < 8; ++j) { orow[64 * j] = v[j]; const f32x4 g = ((const f32x4*)c.norm_g)[c.lane + 64 * j];
            v2u o; o.x = pk2(v[j].x * rstd * g.x, v[j].y * rstd * g.y); o.y = pk2(v[j].z * rstd * g.z, v[j].w * rstd * g.w); h8[64 * j] = o; }
    }
}

__device__ __forceinline__ void phase_rowpass(const Ctx& c, const float* gpost, float coef, const float* gnext) {
    const bf16* Y = (const bf16*)(c.ws + WS_Y); bf16* H = (bf16*)(c.ws + WS_H);
    for (int row = c.gw; row < S_; row += c.NGW) {
        f32x4* xr = (f32x4*)(c.out + (size_t)row * D_) + c.lane; const v2u* yr = (const v2u*)(Y + (size_t)row * D_) + c.lane;
        f32x4 xv[8], yv[8]; float ss = 0.f;
#pragma unroll
        for (int j = 0; j < 8; ++j) { xv[j] = xr[64 * j]; const v2u w = yr[64 * j]; yv[j] = (f32x4){bflo(w.x), bfhi(w.x), bflo(w.y), bfhi(w.y)};
            ss += (yv[j].x * yv[j].x + yv[j].y * yv[j].y) + (yv[j].z * yv[j].z + yv[j].w * yv[j].w); }
        const float rstd = coef / sqrtf(wave_sum(ss) * (1.0f / D_) + NORM_EPS);
        float ss2 = 0.f;
#pragma unroll
        for (int j = 0; j < 8; ++j) { const f32x4 g = ((const f32x4*)gpost)[c.lane + 64 * j]; xv[j] = xv[j] + yv[j] * rstd * g; xr[64 * j] = xv[j];
            ss2 += (xv[j].x * xv[j].x + xv[j].y * xv[j].y) + (xv[j].z * xv[j].z + xv[j].w * xv[j].w); }
        if (gnext) {
            const float rstd2 = 1.0f / sqrtf(wave_sum(ss2) * (1.0f / D_) + NORM_EPS);
            v2u* h8 = (v2u*)(H + (size_t)row * D_) + c.lane;
#pragma unroll
            for (int j = 0; j < 8; ++j) { const f32x4 g = ((const f32x4*)gnext)[c.lane + 64 * j];
                v2u o; o.x = pk2(xv[j].x * rstd2 * g.x, xv[j].y * rstd2 * g.y); o.y = pk2(xv[j].z * rstd2 * g.z, xv[j].w * rstd2 * g.w); h8[64 * j] = o; }
        }
    }
}

__device__ __forceinline__ void sincos_ang(float ang, float& sn, float& cs) {
    double r = (double)ang * 0.15915494309189535; r -= floor(r); const float rf = (float)r;
    sn = __builtin_amdgcn_sinf(rf); cs = __builtin_amdgcn_cosf(rf);
}
__device__ __forceinline__ void rope_pair(bf16* p, int half, float sn, float cs) {
    const float x1 = bf2f(p[0]), x2 = bf2f(p[half]);
    p[0] = (bf16)f2bf(x1 * cs - x2 * sn); p[half] = (bf16)f2bf(x2 * cs + x1 * sn);
}
constexpr float LOG2_RET_BASE = 13.287712379549449f, LOG2_ROPE_THETA = 18.931568569324174f;
__device__ __forceinline__ void phase_rope_even(const Ctx& c) {
    bf16* P = (bf16*)(c.ws + WS_P);
    for (int t = c.gw; t < S_; t += c.NGW) {
        const float pos = (float)c.pos[t]; bf16* row = P + (size_t)t * AB_IN;
        { float sn, cs; sincos_ang(pos * exp2f(-(float)c.lane * (1.0f / 64.0f) * LOG2_RET_BASE), sn, cs);
#pragma unroll 4
          for (int cb = 0; cb < 16; ++cb) rope_pair(row + (cb >> 3) * 1024 + (cb & 7) * 128 + c.lane, 64, sn, cs); }
        { const int i = c.lane & 15; float sn, cs; sincos_ang(pos * exp2f(-(float)i * (1.0f / 16.0f) * LOG2_ROPE_THETA), sn, cs);
#pragma unroll
          for (int j = 0; j < 4; ++j) { const int cb = (c.lane >> 4) + 4 * j; rope_pair(row + 6144 + (cb >> 3) * 1024 + (cb & 7) * 128 + i, 16, sn, cs); } }
    }
}
__device__ __forceinline__ void phase_rope_odd(const Ctx& c) {
    bf16* P = (bf16*)(c.ws + WS_P);
    for (int t = c.gw; t < S_; t += c.NGW) {
        const float pos = (float)c.pos[t]; bf16* row = P + (size_t)t * C_INP;
        const int i = c.lane & 15; float sn, cs; sincos_ang(pos * exp2f(-(float)i * (1.0f / 16.0f) * LOG2_ROPE_THETA), sn, cs);
#pragma unroll
        for (int j = 0; j < 7; ++j) { const int cb = (c.lane >> 4) + 4 * j;
            const int col = cb < 16 ? cb * 128 : (cb < 20 ? 2048 + (cb - 16) * 128 : (cb < 24 ? 3072 + (cb - 20) * 128 : 4096 + (cb - 24) * 128));
            rope_pair(row + col + i, 16, sn, cs); }
    }
}

__device__ __forceinline__ float ret_log_gamma(int h) { const float x = __builtin_amdgcn_exp2f(-5.0f - (float)h);
    return -x * (1.0f + x * (0.5f + x * ((1.0f / 3.0f) + x * (0.25f + x * (0.2f + x * ((1.0f / 6.0f) + x * (1.0f / 7.0f))))))); }
constexpr float RET_SCALE = 0.08838834764831845f;
__device__ __forceinline__ void phase_ret_kv(const Ctx& c) {
    const bf16* P = (const bf16*)(c.ws + WS_P); float* KV = (float*)(c.ws + WS_KV);
    LAS float* Kf = (LAS float*)c.lds; LAS bf16* Vb = (LAS bf16*)(c.lds + 65536);
    for (int u = c.bid; u < 512; u += c.G) {
        const int h = u >> 6, n = u & 63; const float lg = ret_log_gamma(h);
        for (int idx = c.tid; idx < 128 * 16; idx += NTHREADS) { const int r = idx >> 4, ch = idx & 15;
            const v4u v = *(const v4u*)(P + (size_t)(128 * n + r) * AB_IN + 1024 + h * 128 + 8 * ch); const float zs = RET_SCALE * __expf(lg * (float)(127 - r));
            LAS float* d = Kf + r * 128 + 8 * ch;
            d[0] = bflo(v.x) * zs; d[1] = bfhi(v.x) * zs; d[2] = bflo(v.y) * zs; d[3] = bfhi(v.y) * zs; d[4] = bflo(v.z) * zs; d[5] = bfhi(v.z) * zs; d[6] = bflo(v.w) * zs; d[7] = bfhi(v.w) * zs; }
        for (int idx = c.tid; idx < 128 * 32; idx += NTHREADS) { const int r = idx >> 5, ch = idx & 31;
            *(LAS v4u*)(Vb + r * 256 + 8 * ch) = *(const v4u*)(P + (size_t)(128 * n + r) * AB_IN + 2048 + h * 256 + 8 * ch); }
        __syncthreads();
        const int e4 = c.tid & 63, dg = c.tid >> 6;
        f32x4 acc[16];
#pragma unroll
        for (int i = 0; i < 16; ++i) acc[i] = (f32x4){0.f, 0.f, 0.f, 0.f};
        for (int k = 0; k < 128; ++k) {
            const v2u vv = *(const LAS v2u*)(Vb + k * 256 + 4 * e4); const f32x4 v = (f32x4){bflo(vv.x), bfhi(vv.x), bflo(vv.y), bfhi(vv.y)};
#pragma unroll
            for (int i = 0; i < 16; ++i) acc[i] += v * Kf[k * 128 + dg + 8 * i];
        }
#pragma unroll
        for (int i = 0; i < 16; ++i) *(f32x4*)(KV + ((size_t)(h * 64 + n) * 128 + dg + 8 * i) * 256 + 4 * e4) = acc[i];
        __syncthreads();
    }
}
__device__ __forceinline__ void phase_ret_scan(const Ctx& c) {
    const float* KV = (const float*)(c.ws + WS_KV); float* PV = (float*)(c.ws + WS_PREV);
    for (int it = c.bid * NTHREADS + c.tid; it < 8 * 128 * 64; it += c.G * NTHREADS) {
        const int h = it >> 13, rem = it & 8191; const float cd = __expf(ret_log_gamma(h) * 128.0f);
        const size_t off = (size_t)h * 64 * 32768 + (size_t)rem * 4;
        f32x4 st = (f32x4){0.f, 0.f, 0.f, 0.f};
#pragma unroll 4
        for (int n = 0; n < 64; ++n) { const f32x4 kv = *(const f32x4*)(KV + off + (size_t)n * 32768); *(f32x4*)(PV + off + (size_t)n * 32768) = st; st = st * cd + kv; }
    }
}

struct AttnState { float m, l, o0, o1; };
__device__ __forceinline__ float dot128_bf16(const LAS float* qs, const bf16* kr) {
    float acc = 0.f;
#pragma unroll
    for (int ch = 0; ch < 16; ++ch) { const v4u kv = *(const v4u*)(kr + 8 * ch); const f32x4 qa = *(const LAS f32x4*)(qs + 8 * ch), qb = *(const LAS f32x4*)(qs + 8 * ch + 4);
        acc += qa.x * bflo(kv.x) + qa.y * bfhi(kv.x) + qa.z * bflo(kv.y) + qa.w * bfhi(kv.y) + qb.x * bflo(kv.z) + qb.y * bfhi(kv.z) + qb.z * bflo(kv.w) + qb.w * bfhi(kv.w); }
    return acc;
}
__device__ __forceinline__ float dot128_f32(const LAS float* qs, const float* kr) {
    float acc = 0.f;
#pragma unroll
    for (int ch = 0; ch < 32; ++ch) { const f32x4 kv = *(const f32x4*)(kr + 4 * ch); const f32x4 qa = *(const LAS f32x4*)(qs + 4 * ch);
        acc += qa.x * kv.x + qa.y * kv.y + qa.z * kv.z + qa.w * kv.w; }
    return acc;
}
template <class KF> __device__ __forceinline__ void attn_keys_bf16(AttnState& st, const LAS float* qs, int nkeys, const KF& kf, int lane) {
    for (int base = 0; base < nkeys; base += 64) {
        const int kidx = base + lane; const bf16 *kr = nullptr, *vr = nullptr; const bool valid = (kidx < nkeys) && kf(kidx, kr, vr);
        float s = -__builtin_inff(); if (valid) s = dot128_bf16(qs, kr);
        const float mx = wave_max(s);
        if (mx == -__builtin_inff()) continue;
        const float mn = fmaxf(st.m, mx), alpha = __builtin_amdgcn_exp2f(st.m - mn); const float p = valid ? __builtin_amdgcn_exp2f(s - mn) : 0.f;
        st.l = st.l * alpha + wave_sum(p); st.o0 *= alpha; st.o1 *= alpha; st.m = mn;
        const int cnt = (nkeys - base) < 64 ? (nkeys - base) : 64;
        for (int j = 0; j < cnt; ++j) { const float pj = rdlane(p, j); if (pj == 0.f) continue;
            const bf16 *kr2 = nullptr, *vr2 = nullptr; (void)kf(base + j, kr2, vr2);
            const unsigned vv = *(const unsigned*)(vr2 + 2 * lane); st.o0 += pj * bflo(vv); st.o1 += pj * bfhi(vv); }
    }
}
constexpr float ATT_C2 = 0.08838834764831845f * 1.4426950408889634f;

__device__ __forceinline__ void phase_ret_out_dil(const Ctx& c) {
    const bf16* P = (const bf16*)(c.ws + WS_P); const float* PV = (const float*)(c.ws + WS_PREV); bf16* CAT = (bf16*)(c.ws + WS_CAT);
    LAS float* qs = (LAS float*)(c.lds + c.wave * 1024); LAS float* sS = qs + 128;
    for (int task = c.gw; task < 16 * S_; task += c.NGW) {
        const int hh = task >> 13, t = task & (S_ - 1);
        if (hh < 8) {
            const int h = hh, n = t >> 7, q = t & 127; const float lg = ret_log_gamma(h);
            { const unsigned w = *(const unsigned*)(P + (size_t)t * AB_IN + h * 128 + 2 * c.lane); qs[2 * c.lane] = bflo(w); qs[2 * c.lane + 1] = bfhi(w); }
            LDS_WAIT();
#pragma unroll
            for (int g2 = 0; g2 < 2; ++g2) { const int k = c.lane + 64 * g2; float s = 0.f;
                if (k <= q) s = dot128_bf16(qs, P + (size_t)(128 * n + k) * AB_IN + 1024 + h * 128) * RET_SCALE * __expf(lg * (float)(q - k));
                sS[k] = s; }
            LDS_WAIT();
            f32x4 o = (f32x4){0.f, 0.f, 0.f, 0.f};
            const float* pv = PV + (size_t)(h * 64 + n) * 32768 + 4 * c.lane;
#pragma unroll 8
            for (int d = 0; d < 128; ++d) o += *(const f32x4*)(pv + d * 256) * qs[d];
            o = o * __expf(lg * (float)(q + 1));
            const bf16* vb = P + (size_t)(128 * n) * AB_IN + 2048 + h * 256 + 4 * c.lane;
            for (int k = 0; k <= q; ++k) { const v2u vv = *(const v2u*)(vb + (size_t)k * AB_IN); const float sk = sS[k];
                o += (f32x4){bflo(vv.x), bfhi(vv.x), bflo(vv.y), bfhi(vv.y)} * sk; }
            const float mean = wave_sum((o.x + o.y) + (o.z + o.w)) * (1.0f / 256.0f);
            const f32x4 dm = o - mean; const float var = wave_sum((dm.x * dm.x + dm.y * dm.y) + (dm.z * dm.z + dm.w * dm.w)) * (1.0f / 256.0f);
            const float rs = 1.0f / sqrtf(var + NORM_EPS);
            const v2u gv = *(const v2u*)(P + (size_t)t * AB_IN + 4096 + h * 256 + 4 * c.lane);
            const f32x4 g = (f32x4){bflo(gv.x), bfhi(gv.x), bflo(gv.y), bfhi(gv.y)};
            v2u ov; ov.x = pk2(g.x / (1.0f + __expf(-g.x)) * dm.x * rs, g.y / (1.0f + __expf(-g.y)) * dm.y * rs); ov.y = pk2(g.z / (1.0f + __expf(-g.z)) * dm.z * rs, g.w / (1.0f + __expf(-g.w)) * dm.w * rs);
            *(v2u*)(CAT + (size_t)t * AB_OUT + h * 256 + 4 * c.lane) = ov;
            LDS_WAIT();
        } else {
            const int h = hh - 8;
            { const unsigned w = *(const unsigned*)(P + (size_t)t * AB_IN + 6144 + h * 128 + 2 * c.lane); qs[2 * c.lane] = bflo(w) * ATT_C2; qs[2 * c.lane + 1] = bfhi(w) * ATT_C2; }
            LDS_WAIT();
            AttnState st; st.m = -__builtin_inff(); st.l = 0.f; st.o0 = 0.f; st.o1 = 0.f;
            const bf16* kb = P + 7168 + h * 128; const bf16* vb = P + 8192 + h * 128;
#pragma unroll 1
            for (int pi = 0; pi < 3; ++pi) { const int dil = pi == 0 ? 1 : (pi == 1 ? 4 : 16);
                auto kf = [=](int kidx, const bf16*& kr, const bf16*& vr) -> bool { const int tok = t - kidx * dil; const int tk = tok < 0 ? 0 : tok; kr = kb + (size_t)tk * AB_IN; vr = vb + (size_t)tk * AB_IN; return tok >= 0; };
                attn_keys_bf16(st, qs, 129, kf, c.lane); }
            const float inv = 1.0f / st.l;
            *(unsigned*)(CAT + (size_t)t * AB_OUT + 2048 + h * 128 + 2 * c.lane) = pk2(st.o0 * inv, st.o1 * inv);
            LDS_WAIT();
        }
    }
}

__device__ __forceinline__ float gelu_tanh(float x) { const float u = 0.7978845608028654f * (x + 0.044715f * x * x * x); const float t = 1.0f - 2.0f / (1.0f + __expf(2.0f * u)); return 0.5f * x * (1.0f + t); }
__device__ __forceinline__ void phase_compress(const Ctx& c, int j) {
    const bf16* P = (const bf16*)(c.ws + WS_P);
    LAS float* Xs = (LAS float*)c.lds; LAS float* PEs = (LAS float*)(c.lds + 73728); LAS float* Hs = (LAS float*)(c.lds + 90112);
    for (int u = c.bid; u < 512; u += c.G) {
        const int tensor = u >> 8, g = (u >> 6) & 3, nb = u & 63, tok0 = 128 * nb;
        const float* w1 = (tensor ? c.cv_w1 : c.ck_w1) + (size_t)j * 4096 * 256; const float* w2 = (tensor ? c.cv_w2 : c.ck_w2) + (size_t)j * 256 * 128; const float* pe = (tensor ? c.pe_v : c.pe_k) + (size_t)j * 4096;
        const int colb = (tensor ? 2560 : 2048) + g * 128;
        for (int idx = c.tid; idx < 144 * 16; idx += NTHREADS) { const int r = idx >> 4, ch = idx & 15, tok = tok0 + r;
            v4u v = (v4u){0u, 0u, 0u, 0u}; if (tok < S_) v = *(const v4u*)(P + (size_t)tok * C_INP + colb + 8 * ch);
            LAS float* d = Xs + r * 128 + 8 * ch;
            d[0] = bflo(v.x); d[1] = bfhi(v.x); d[2] = bflo(v.y); d[3] = bfhi(v.y); d[4] = bflo(v.z); d[5] = bfhi(v.z); d[6] = bflo(v.w); d[7] = bfhi(v.w); }
        for (int idx = c.tid; idx < 4096; idx += NTHREADS) PEs[idx] = pe[idx];
        __syncthreads();
        { const int jc = c.tid & 255, half = c.tid >> 8; float acc[4] = {0.f, 0.f, 0.f, 0.f};
          for (int l = 0; l < 32; ++l) {
#pragma unroll 4
            for (int d = 0; d < 128; ++d) { const float w = w1[(size_t)(l * 128 + d) * 256 + jc]; const float pv = PEs[l * 128 + d];
#pragma unroll
                for (int r = 0; r < 4; ++r) acc[r] += (Xs[(16 * (4 * half + r) + l) * 128 + d] + pv) * w; } }
#pragma unroll
          for (int r = 0; r < 4; ++r) Hs[(4 * half + r) * 256 + jc] = gelu_tanh(acc[r]); }
        __syncthreads();
        { const int r = c.tid >> 6, c2 = 2 * (c.tid & 63); float o0 = 0.f, o1 = 0.f;
#pragma unroll 4
          for (int jj = 0; jj < 256; ++jj) { const float hv = Hs[r * 256 + jj]; const f32x2 w = *(const f32x2*)(w2 + (size_t)jj * 128 + c2); o0 += hv * w.x; o1 += hv * w.y; }
          const int n = 8 * nb + r; if (n == 511) { o0 = 0.f; o1 = 0.f; }
          bf16* dst = (bf16*)(c.ws + (tensor ? WS_CV : WS_CK)) + ((size_t)(g * 512 + n) * 128 + c2);
          *(unsigned*)dst = pk2(o0, o1); }
        __syncthreads();
    }
}
typedef short bf16x8 __attribute__((ext_vector_type(8)));
typedef short s16x4 __attribute__((ext_vector_type(4)));
__device__ __forceinline__ s16x4 vtr(const LAS unsigned char* p) { return __builtin_bit_cast(s16x4, __builtin_amdgcn_ds_read_tr16_b64_v4i16((LAS s16x4*)p)); }
__device__ __forceinline__ f32x4 mfma16(bf16x8 a, bf16x8 b, f32x4 c) { return __builtin_amdgcn_mfma_f32_16x16x32_bf16(a, b, c, 0, 0, 0); }
__device__ __forceinline__ int off_b(int row, int ch) { return 256 * row + 16 * (ch ^ (((row & 3) << 2) | ((row >> 2) & 3))); }
__device__ __forceinline__ unsigned cvtpk(float lo, float hi) { unsigned r; asm volatile("v_cvt_pk_bf16_f32 %0, %1, %2" : "=v"(r) : "v"(lo), "v"(hi)); return r; }
struct LaneGeo { int qi, g4; int koff[4]; int voff[8]; };
__device__ __forceinline__ LaneGeo lane_geo(int lane) {
    LaneGeo G; G.qi = lane & 15; G.g4 = lane >> 4;
    const int kx = ((G.qi & 3) << 2) | (G.qi >> 2);
#pragma unroll
    for (int ks = 0; ks < 4; ++ks) G.koff[ks] = 256 * G.qi + 16 * ((4 * ks + G.g4) ^ kx);
    const int q = G.qi >> 2, p = G.qi & 3, vx = (q << 2) | G.g4;
#pragma unroll
    for (int db = 0; db < 8; ++db) G.voff[db] = 256 * (4 * G.g4 + q) + 16 * ((2 * db + (p >> 1)) ^ vx) + 8 * (p & 1);
    return G;
}
template <class RP> __device__ __forceinline__ void tile_dma(LAS unsigned char* Kb, LAS unsigned char* Vb, const RP& rp, int wave, int lane) {
#pragma unroll
    for (int i = 0; i < 2; ++i) { const int p = wave + 8 * i, row = 4 * p + (lane >> 4), ch = (lane & 15) ^ (((row & 3) << 2) | ((row >> 2) & 3)); const bf16 *kp = nullptr, *vp = nullptr; rp(row, kp, vp);
        __builtin_amdgcn_global_load_lds((const unsigned*)(kp + 8 * ch), (LAS unsigned*)(Kb + 1024 * p), 16, 0, 0);
        __builtin_amdgcn_global_load_lds((const unsigned*)(vp + 8 * ch), (LAS unsigned*)(Vb + 1024 * p), 16, 0, 0); }
}
#define TILE_SYNC() do { asm volatile("s_waitcnt vmcnt(0)" ::: "memory"); __syncthreads(); } while (0)
template <class MaskF> __device__ __forceinline__ void attn_scores(f32x4 (&s)[2][4], const LAS unsigned char* Kb, const LaneGeo& G, const bf16x8 (&qf)[2][4], bool need_mask, const MaskF& mask) {
#pragma unroll
    for (int kg = 0; kg < 4; ++kg) { s[0][kg] = (f32x4){0.f, 0.f, 0.f, 0.f}; s[1][kg] = (f32x4){0.f, 0.f, 0.f, 0.f};
#pragma unroll
        for (int ks = 0; ks < 4; ++ks) { const bf16x8 a = *(const LAS bf16x8*)(Kb + 4096 * kg + G.koff[ks]); s[0][kg] = mfma16(a, qf[0][ks], s[0][kg]); s[1][kg] = mfma16(a, qf[1][ks], s[1][kg]); }
        asm volatile("" ::: "memory"); }
#pragma unroll
    for (int qg = 0; qg < 2; ++qg)
#pragma unroll
        for (int kg = 0; kg < 4; ++kg)
#pragma unroll
            for (int r = 0; r < 4; ++r) { float v = s[qg][kg][r] * ATT_C2; if (need_mask && !mask(qg, 16 * kg + 4 * G.g4 + r)) v = -__builtin_inff(); s[qg][kg][r] = v; }
}
template <class MaskF> __device__ __forceinline__ void attn_tile(const LAS unsigned char* Kb, const LAS unsigned char* Vb, const LaneGeo& G, const bf16x8 (&qf)[2][4],
                                                                 float (&m)[2], float (&l)[2], f32x4 (&o)[2][8], bool need_mask, const MaskF& mask) {
    f32x4 s[2][4];
    attn_scores(s, Kb, G, qf, need_mask, mask);
    bf16x8 pb[2][2];
#pragma unroll
    for (int qg = 0; qg < 2; ++qg) {
        float mx = -__builtin_inff();
#pragma unroll
        for (int kg = 0; kg < 4; ++kg) mx = fmaxf(mx, fmaxf(fmaxf(s[qg][kg][0], s[qg][kg][1]), fmaxf(s[qg][kg][2], s[qg][kg][3])));
        mx = fmaxf(mx, __shfl_xor(mx, 16)); mx = fmaxf(mx, __shfl_xor(mx, 32));
        const float mn = fmaxf(m[qg], mx), alpha = __builtin_amdgcn_exp2f(m[qg] - mn); m[qg] = mn;
        float ps = 0.f;
#pragma unroll
        for (int kg = 0; kg < 4; ++kg)
#pragma unroll
            for (int r = 0; r < 4; ++r) { const float p = __builtin_amdgcn_exp2f(s[qg][kg][r] - mn); s[qg][kg][r] = p; ps += p; }
        l[qg] = l[qg] * alpha + ps;
#pragma unroll
        for (int db = 0; db < 8; ++db) o[qg][db] *= alpha;
#pragma unroll
        for (int k2 = 0; k2 < 2; ++k2) { v4u w; w.x = cvtpk(s[qg][2 * k2][0], s[qg][2 * k2][1]); w.y = cvtpk(s[qg][2 * k2][2], s[qg][2 * k2][3]);
            w.z = cvtpk(s[qg][2 * k2 + 1][0], s[qg][2 * k2 + 1][1]); w.w = cvtpk(s[qg][2 * k2 + 1][2], s[qg][2 * k2 + 1][3]); pb[qg][k2] = __builtin_bit_cast(bf16x8, w); }
    }
#pragma unroll
    for (int k2 = 0; k2 < 2; ++k2)
#pragma unroll
        for (int db = 0; db < 8; ++db) { const s16x4 lo = vtr(Vb + 8192 * k2 + G.voff[db]), hi = vtr(Vb + 8192 * k2 + 4096 + G.voff[db]);
            const bf16x8 vf = __builtin_shufflevector(lo, hi, 0, 1, 2, 3, 4, 5, 6, 7);
            o[0][db] = mfma16(vf, pb[0][k2], o[0][db]); o[1][db] = mfma16(vf, pb[1][k2], o[1][db]);
            if ((db & 3) == 3) asm volatile("" ::: "memory"); }
}
__device__ __forceinline__ float sigmoid_f(float x) { return 1.0f / (1.0f + __expf(-x)); }
constexpr int ATT_K0 = 0, ATT_K1 = 16384, ATT_V0 = 32768, ATT_V1 = 49152, ATT_X = 65536;

#define NSA_UNIT_SETUP() \
    const int g = u >> 7, tb = u & 127, t0 = 64 * tb; int qt[2]; const bf16* qrow[2]; bf16x8 qf[2][4]; \
    _Pragma("unroll") for (int qg = 0; qg < 2; ++qg) { qt[qg] = t0 + 8 * c.wave + 4 * qg + (G.qi >> 2); qrow[qg] = P + (size_t)qt[qg] * C_INP; \
        _Pragma("unroll") for (int ks = 0; ks < 4; ++ks) qf[qg][ks] = *(const bf16x8*)(qrow[qg] + (4 * g + (G.qi & 3)) * 128 + 32 * ks + 8 * G.g4); } \
    float m[2] = {-1e30f, -1e30f}, l[2] = {0.f, 0.f}; f32x4 o[2][8]; \
    _Pragma("unroll") for (int qg = 0; qg < 2; ++qg) _Pragma("unroll") for (int db = 0; db < 8; ++db) o[qg][db] = (f32x4){0.f, 0.f, 0.f, 0.f};

__device__ __forceinline__ void phase_nsa_window(const Ctx& c) {
    const bf16* P = (const bf16*)(c.ws + WS_P); bf16* OACC = (bf16*)(c.ws + WS_OACC);
    const LaneGeo G = lane_geo(c.lane);
    for (int u = c.bid; u < 512; u += c.G) {
        NSA_UNIT_SETUP();
        const bf16* kb = P + 4096 + g * 128; const bf16* vb = P + 4608 + g * 128;
        const int Tf = tb >= 8 ? 0 : 8 - tb;
        { const int k0 = t0 - 512 + 64 * Tf; auto rp = [=](int row, const bf16*& kp, const bf16*& vp) -> void { kp = kb + (size_t)(k0 + row) * C_INP; vp = vb + (size_t)(k0 + row) * C_INP; };
          tile_dma(c.lds + ATT_K0, c.lds + ATT_V0, rp, c.wave, c.lane); }
        TILE_SYNC();
        for (int T = Tf; T <= 8; ++T) {
            const int cur = (T - Tf) & 1, k0 = t0 - 512 + 64 * T;
            if (T < 8) { const int k1 = k0 + 64; auto rp = [=](int row, const bf16*& kp, const bf16*& vp) -> void { kp = kb + (size_t)(k1 + row) * C_INP; vp = vb + (size_t)(k1 + row) * C_INP; }; tile_dma(c.lds + (cur ? ATT_K0 : ATT_K1), c.lds + (cur ? ATT_V0 : ATT_V1), rp, c.wave, c.lane); }
            const int dq0 = qt[0] - k0, dq1 = qt[1] - k0;
            auto mask = [=](int qg, int key) -> bool { return (unsigned)((qg ? dq1 : dq0) - key) < 512u; };
            attn_tile(c.lds + (cur ? ATT_K1 : ATT_K0), c.lds + (cur ? ATT_V1 : ATT_V0), G, qf, m, l, o, T == 0 || T == 8, mask);
            TILE_SYNC();
        }
#pragma unroll
        for (int qg = 0; qg < 2; ++qg) { float lt = l[qg]; lt += __shfl_xor(lt, 16); lt += __shfl_xor(lt, 32);
            const int h = 4 * g + (G.qi & 3); const float sc = sigmoid_f(bf2f(qrow[qg][5120 + 3 * h + 2])) / lt;
            bf16* dst = OACC + (size_t)qt[qg] * C_OUT + h * 128 + 4 * G.g4;
#pragma unroll
            for (int db = 0; db < 8; ++db) { v2u w; w.x = cvtpk(o[qg][db][0] * sc, o[qg][db][1] * sc); w.y = cvtpk(o[qg][db][2] * sc, o[qg][db][3] * sc); *(v2u*)(dst + 16 * db) = w; } }
    }
}
constexpr int IMP_LD = 132;
__device__ __forceinline__ void phase_nsa_cmp(const Ctx& c) {
    const bf16* P = (const bf16*)(c.ws + WS_P); bf16* OACC = (bf16*)(c.ws + WS_OACC); unsigned* BM = (unsigned*)(c.ws + WS_BM);
    const bf16* CK = (const bf16*)(c.ws + WS_CK); const bf16* CV = (const bf16*)(c.ws + WS_CV);
    const LaneGeo G = lane_geo(c.lane);
    LAS float* imp = (LAS float*)(c.lds + ATT_X);
    for (int u = c.bid; u < 512; u += c.G) {
        NSA_UNIT_SETUP();
        const bf16* kb = CK + (size_t)g * 512 * 128; const bf16* vb = CV + (size_t)g * 512 * 128;
        const int ncmax = ((t0 + 32) >> 4) + 1, NT = (ncmax + 63) >> 6;
        int nmax[2]; float gate[2];
#pragma unroll
        for (int qg = 0; qg < 2; ++qg) { nmax[qg] = qt[qg] >= 31 ? ((qt[qg] - 31) >> 4) : -1; gate[qg] = sigmoid_f(bf2f(qrow[qg][5120 + 3 * (4 * g + (G.qi & 3)) + 0])); }
        for (int i = c.tid; i < 64 * IMP_LD; i += NTHREADS) imp[i] = 0.f;
        { auto rp = [=](int row, const bf16*& kp, const bf16*& vp) -> void { kp = kb + (size_t)row * 128; vp = vb + (size_t)row * 128; };
          tile_dma(c.lds + ATT_K0, c.lds + ATT_V0, rp, c.wave, c.lane); }
        TILE_SYNC();
        for (int T = 0; T < NT; ++T) {
            const int cur = T & 1, n0 = 64 * T;
            if (T + 1 < NT) { const int n1 = n0 + 64; auto rp = [=](int row, const bf16*& kp, const bf16*& vp) -> void { kp = kb + (size_t)(n1 + row) * 128; vp = vb + (size_t)(n1 + row) * 128; }; tile_dma(c.lds + (cur ? ATT_K0 : ATT_K1), c.lds + (cur ? ATT_V0 : ATT_V1), rp, c.wave, c.lane); }
            const int d0 = nmax[0] - n0, d1 = nmax[1] - n0;
            auto mask = [=](int qg, int key) -> bool { return key <= (qg ? d1 : d0); };
            attn_tile(c.lds + (cur ? ATT_K1 : ATT_K0), c.lds + (cur ? ATT_V1 : ATT_V0), G, qf, m, l, o, true, mask);
            TILE_SYNC();
        }
        float linv[2];
#pragma unroll
        for (int qg = 0; qg < 2; ++qg) { float lt = l[qg]; lt += __shfl_xor(lt, 16); lt += __shfl_xor(lt, 32); linv[qg] = lt > 0.f ? 1.0f / lt : 0.f; }
#pragma unroll
        for (int qg = 0; qg < 2; ++qg) { const int h = 4 * g + (G.qi & 3); const float sc = gate[qg] * linv[qg];
            bf16* dst = OACC + (size_t)qt[qg] * C_OUT + h * 128 + 4 * G.g4;
#pragma unroll
            for (int db = 0; db < 8; ++db) { const v2u old = *(const v2u*)(dst + 16 * db);
                v2u w; w.x = cvtpk(bflo(old.x) + o[qg][db][0] * sc, bfhi(old.x) + o[qg][db][1] * sc); w.y = cvtpk(bflo(old.y) + o[qg][db][2] * sc, bfhi(old.y) + o[qg][db][3] * sc); *(v2u*)(dst + 16 * db) = w; } }
        { auto rp = [=](int row, const bf16*& kp, const bf16*& vp) -> void { kp = kb + (size_t)row * 128; vp = vb + (size_t)row * 128; };
          tile_dma(c.lds + ATT_K0, c.lds + ATT_V0, rp, c.wave, c.lane); }
        TILE_SYNC();
        for (int T = 0; T < NT; ++T) {
            const int cur = T & 1, n0 = 64 * T;
            if (T + 1 < NT) { const int n1 = n0 + 64; auto rp = [=](int row, const bf16*& kp, const bf16*& vp) -> void { kp = kb + (size_t)(n1 + row) * 128; vp = vb + (size_t)(n1 + row) * 128; }; tile_dma(c.lds + (cur ? ATT_K0 : ATT_K1), c.lds + (cur ? ATT_V0 : ATT_V1), rp, c.wave, c.lane); }
            const int d0 = nmax[0] - n0, d1 = nmax[1] - n0;
            auto mask = [=](int qg, int key) -> bool { return key <= (qg ? d1 : d0); };
            f32x4 s[2][4];
            attn_scores(s, c.lds + (cur ? ATT_K1 : ATT_K0), G, qf, true, mask);
#pragma unroll
            for (int qg = 0; qg < 2; ++qg)
#pragma unroll
                for (int kg = 0; kg < 4; ++kg) {
                    const float p0 = __builtin_amdgcn_exp2f(s[qg][kg][0] - m[qg]), p1 = __builtin_amdgcn_exp2f(s[qg][kg][1] - m[qg]), p2 = __builtin_amdgcn_exp2f(s[qg][kg][2] - m[qg]), p3 = __builtin_amdgcn_exp2f(s[qg][kg][3] - m[qg]);
                    float sa = ((p0 + p1) + (p2 + p3)) * linv[qg], sb = p3 * linv[qg];
                    sa += __shfl_xor(sa, 1); sa += __shfl_xor(sa, 2); sb += __shfl_xor(sb, 1); sb += __shfl_xor(sb, 2);
                    if ((G.qi & 3) == 0) { const int tl = 8 * c.wave + 4 * qg + (G.qi >> 2), bA = 16 * T + 4 * kg + G.g4;
                        __hip_atomic_fetch_add(imp + tl * IMP_LD + bA, sa, __ATOMIC_RELAXED, __HIP_MEMORY_SCOPE_WORKGROUP);
                        if (bA + 1 < 128) __hip_atomic_fetch_add(imp + tl * IMP_LD + bA + 1, sb, __ATOMIC_RELAXED, __HIP_MEMORY_SCOPE_WORKGROUP); }
                }
            TILE_SYNC();
        }
        for (int ti = 0; ti < 8; ++ti) {
            const int tl = 8 * c.wave + ti, t = t0 + tl, curb = t >> 6; float sc[2];
#pragma unroll
            for (int i = 0; i < 2; ++i) { const int mb = c.lane + 64 * i; const bool forced = (mb == 0) || (mb == curb) || (mb == curb - 1);
                sc[i] = (mb <= curb) ? imp[tl * IMP_LD + mb] + (forced ? 1e4f : 0.f) : -__builtin_inff(); }
            int rk0 = 0, rk1 = 0;
#pragma unroll 4
            for (int jj = 0; jj < 64; ++jj) { const float a = rdlane(sc[0], jj), b = rdlane(sc[1], jj);
                rk0 += (a > sc[0] || (a == sc[0] && jj < c.lane)) ? 1 : 0; rk0 += (b > sc[0]) ? 1 : 0;
                rk1 += (a >= sc[1]) ? 1 : 0; rk1 += (b > sc[1] || (b == sc[1] && jj < c.lane)) ? 1 : 0; }
            const bool sel0 = (sc[0] > -__builtin_inff()) && rk0 < 16, sel1 = (sc[1] > -__builtin_inff()) && rk1 < 16;
            const unsigned long long mk0 = __ballot(sel0), mk1 = __ballot(sel1);
            if (c.lane == 0) *(v4u*)(BM + ((size_t)g * S_ + t) * 4) = (v4u){(unsigned)mk0, (unsigned)(mk0 >> 32), (unsigned)mk1, (unsigned)(mk1 >> 32)};
        }
        __syncthreads();
    }
}
__device__ __forceinline__ void phase_nsa_sel(const Ctx& c) {
    const bf16* P = (const bf16*)(c.ws + WS_P); const bf16* OACC = (const bf16*)(c.ws + WS_OACC); bf16* CAT = (bf16*)(c.ws + WS_CAT); const unsigned* BM = (const unsigned*)(c.ws + WS_BM);
    const LaneGeo G = lane_geo(c.lane);
    LAS unsigned* bms = (LAS unsigned*)(c.lds + ATT_X);
    for (int u = c.bid; u < 512; u += c.G) {
        NSA_UNIT_SETUP();
        const bf16* kb = P + 3072 + g * 128; const bf16* vb = P + 3584 + g * 128;
        if (c.tid < 256) bms[c.tid] = BM[((size_t)g * S_ + t0) * 4 + c.tid];
        { auto rp = [=](int row, const bf16*& kp, const bf16*& vp) -> void { kp = kb + (size_t)row * C_INP; vp = vb + (size_t)row * C_INP; };
          tile_dma(c.lds + ATT_K0, c.lds + ATT_V0, rp, c.wave, c.lane); }
        TILE_SYNC();
        const int tl0 = 8 * c.wave + (G.qi >> 2), tl1 = tl0 + 4;
        for (int T = 0; T <= tb; ++T) {
            const int cur = T & 1, k0 = 64 * T;
            if (T < tb) { const int k1 = k0 + 64; auto rp = [=](int row, const bf16*& kp, const bf16*& vp) -> void { kp = kb + (size_t)(k1 + row) * C_INP; vp = vb + (size_t)(k1 + row) * C_INP; }; tile_dma(c.lds + (cur ? ATT_K0 : ATT_K1), c.lds + (cur ? ATT_V0 : ATT_V1), rp, c.wave, c.lane); }
            const bool b0 = (bms[tl0 * 4 + (T >> 5)] >> (T & 31)) & 1u, b1 = (bms[tl1 * 4 + (T >> 5)] >> (T & 31)) & 1u;
            if (__ballot(b0 || b1) != 0ull) {
                const int dq0 = qt[0] - k0, dq1 = qt[1] - k0;
                auto mask = [=](int qg, int key) -> bool { return (qg ? b1 : b0) && key <= (qg ? dq1 : dq0); };
                attn_tile(c.lds + (cur ? ATT_K1 : ATT_K0), c.lds + (cur ? ATT_V1 : ATT_V0), G, qf, m, l, o, true, mask);
            }
            TILE_SYNC();
        }
#pragma unroll
        for (int qg = 0; qg < 2; ++qg) { float lt = l[qg]; lt += __shfl_xor(lt, 16); lt += __shfl_xor(lt, 32);
            const int h = 4 * g + (G.qi & 3); const float sc = sigmoid_f(bf2f(qrow[qg][5120 + 3 * h + 1])) / lt;
            const bf16* src = OACC + (size_t)qt[qg] * C_OUT + h * 128 + 4 * G.g4; bf16* dst = CAT + (size_t)qt[qg] * C_OUT + h * 128 + 4 * G.g4;
#pragma unroll
            for (int db = 0; db < 8; ++db) { const v2u old = *(const v2u*)(src + 16 * db);
                v2u w; w.x = cvtpk(bflo(old.x) + o[qg][db][0] * sc, bfhi(old.x) + o[qg][db][1] * sc); w.y = cvtpk(bflo(old.y) + o[qg][db][2] * sc, bfhi(old.y) + o[qg][db][3] * sc); *(v2u*)(dst + 16 * db) = w; } }
    }
}

struct Args { const float* in[16]; float* out; unsigned char* ws; int ph_lo, ph_hi; };
__device__ __forceinline__ Ctx make_ctx(const Args& args, LAS unsigned char* lds, int wave_s) {
    Ctx c; c.lds = lds;
    const float* const* in = args.in;
    c.x = in[0]; c.pos = (const int*)in[1]; c.norm_g = in[2]; c.w1 = in[3]; c.w3 = in[4]; c.w2 = in[5]; c.ab_in = in[6]; c.ab_out = in[7];
    c.c_in = in[8]; c.c_out = in[9]; c.ck_w1 = in[10]; c.ck_w2 = in[11]; c.cv_w1 = in[12]; c.cv_w2 = in[13]; c.pe_k = in[14]; c.pe_v = in[15];
    float* out = args.out; unsigned char* ws = args.ws; asm volatile("" : "+s"(out), "+s"(ws));
    c.out = out; c.ws = ws;
    int lane, bid = blockIdx.x, G = gridDim.x;
    asm volatile("v_mbcnt_lo_u32_b32 %0, -1, 0\n\tv_mbcnt_hi_u32_b32 %0, -1, %0" : "=v"(lane));
    asm volatile("" : "+s"(wave_s), "+s"(bid), "+s"(G));
    c.lane = lane; c.wave = wave_s; c.tid = wave_s * 64 + lane; c.bid = bid; c.G = G; c.gw = c.bid * NWAVES + c.wave; c.NGW = c.G * NWAVES;
    return c;
}
__global__ void __launch_bounds__(NTHREADS, 2) mk_fwd(Args args) {
    extern __shared__ __attribute__((aligned(16))) unsigned char lds_raw[];
    LAS unsigned char* const lds = (LAS unsigned char*)lds_raw;
    for (int u = threadIdx.x; u < (LDS_BYTES - RING_BYTES) / 4; u += NTHREADS) ((LAS unsigned*)(lds + RING_BYTES))[u] = 0u;
    __syncthreads();
    const int lo = args.ph_lo, hi = args.ph_hi; const int wave_s = __builtin_amdgcn_readfirstlane(threadIdx.x >> 6);
#if MK_FUSED
    XcdBarrier bar = xcd_barrier_post((unsigned*)(args.ws + WS_CTL) + CW_BAR, (volatile LAS unsigned*)(lds + MISC_OFF) + 8);
#define GRID_BAR() xcd_barrier(bar)
#else
#define GRID_BAR() do { } while (0)
#endif
#define IN(k) (lo <= (k) && (k) < hi)
#define SEAM(k) do { if (IN(k) && IN((k) + 1)) GRID_BAR(); } while (0)
#define CTX() const Ctx c = make_ctx(args, lds, wave_s)
#define WSP(T, off) ((T*)(c.ws + (off)))

    if (IN(0)) { CTX(); phase_prologue(c); }
    SEAM(0);
#pragma unroll 1
    for (int L = 0; L < DEPTH; ++L) {
        const int base = 1 + 13 * L, jx = L >> 1; const bool odd = (L & 1) != 0;
        if (IN(base + 0)) { CTX(); pg8::Gemm g{WSP(bf16, WS_H), (const bf16*)(c.ws + WS_W13 + (size_t)(2 * L) * SZ_W13), S_, NUP, D_}; pg8::StaticOrder So; So.init(S_, NUP, c.G, c.bid);
            pg8::EpiSwiglu E{WSP(bf16, WS_P), DFF}; pg8::gemm_phase<pg8::EpiSwiglu, pg8::StaticOrder, true, true>(c.lds, g, So, E, c.tid); }
        SEAM(base + 0);
        if (IN(base + 1)) { CTX(); pg8::Gemm g{WSP(bf16, WS_P), (const bf16*)(c.ws + WS_W2 + (size_t)(2 * L) * SZ_W2), S_, D_, DFF}; pg8::StaticOrder So; So.init(S_, D_, c.G, c.bid);
            pg8::EpiStore E{WSP(bf16, WS_Y), D_}; pg8::gemm_phase<pg8::EpiStore, pg8::StaticOrder, true, true>(c.lds, g, So, E, c.tid); }
        SEAM(base + 1);
        if (IN(base + 2)) { CTX(); const float* ng = c.norm_g + (size_t)L * 6 * D_; phase_rowpass(c, ng + 1 * D_, 0.5f, ng + 2 * D_); }
        SEAM(base + 2);
        if (!odd) {
            if (IN(base + 3)) { CTX(); pg8::Gemm g{WSP(bf16, WS_H), (const bf16*)(c.ws + WS_ABIN + (size_t)jx * SZ_ABIN), S_, AB_IN, D_}; pg8::StaticOrder So; So.init(S_, AB_IN, c.G, c.bid);
                pg8::EpiStore E{WSP(bf16, WS_P), AB_IN}; pg8::gemm_phase<pg8::EpiStore, pg8::StaticOrder, true, true>(c.lds, g, So, E, c.tid); }
            SEAM(base + 3);
            if (IN(base + 4)) { CTX(); phase_rope_even(c); }
            SEAM(base + 4);
            if (IN(base + 5)) { CTX(); phase_ret_kv(c); }
            SEAM(base + 5);
            if (IN(base + 6)) { CTX(); phase_ret_scan(c); }
            SEAM(base + 6);
            if (IN(base + 7)) { CTX(); phase_ret_out_dil(c); }
            SEAM(base + 7);
            if (IN(base + 8)) { CTX(); pg8::Gemm g{WSP(bf16, WS_CAT), (const bf16*)(c.ws + WS_ABOUT + (size_t)jx * SZ_ABOUT), S_, D_, AB_OUT}; pg8::StaticOrder So; So.init(S_, D_, c.G, c.bid);
                pg8::EpiStore E{WSP(bf16, WS_Y), D_}; pg8::gemm_phase<pg8::EpiStore, pg8::StaticOrder, true, true>(c.lds, g, So, E, c.tid); }
            SEAM(base + 8);
        } else {
            if (IN(base + 3)) { CTX(); pg8::Gemm g{WSP(bf16, WS_H), (const bf16*)(c.ws + WS_CIN + (size_t)jx * SZ_CIN), S_, C_INP, D_}; pg8::StaticOrder So; So.init(S_, C_INP, c.G, c.bid);
                pg8::EpiStore E{WSP(bf16, WS_P), C_INP}; pg8::gemm_phase<pg8::EpiStore, pg8::StaticOrder, true, true>(c.lds, g, So, E, c.tid); }
            SEAM(base + 3);
            if (IN(base + 4)) { CTX(); phase_rope_odd(c); }
            SEAM(base + 4);
            if (IN(base + 5)) { { CTX(); phase_compress(c, jx); } { CTX(); phase_nsa_window(c); } }
            SEAM(base + 5);
            if (IN(base + 6)) { CTX(); phase_nsa_cmp(c); }
            SEAM(base + 6);
            if (IN(base + 7)) { CTX(); phase_nsa_sel(c); }
            SEAM(base + 7);
            if (IN(base + 8)) { CTX(); pg8::Gemm g{WSP(bf16, WS_CAT), (const bf16*)(c.ws + WS_COUT + (size_t)jx * SZ_COUT), S_, D_, C_OUT}; pg8::StaticOrder So; So.init(S_, D_, c.G, c.bid);
                pg8::EpiStore E{WSP(bf16, WS_Y), D_}; pg8::gemm_phase<pg8::EpiStore, pg8::StaticOrder, true, true>(c.lds, g, So, E, c.tid); }
            SEAM(base + 8);
        }
        if (IN(base + 9)) { CTX(); const float* ng = c.norm_g + (size_t)L * 6 * D_; phase_rowpass(c, ng + 3 * D_, 1.0f, ng + 4 * D_); }
        SEAM(base + 9);
        if (IN(base + 10)) { CTX(); pg8::Gemm g{WSP(bf16, WS_H), (const bf16*)(c.ws + WS_W13 + (size_t)(2 * L + 1) * SZ_W13), S_, NUP, D_}; pg8::StaticOrder So; So.init(S_, NUP, c.G, c.bid);
            pg8::EpiSwiglu E{WSP(bf16, WS_P), DFF}; pg8::gemm_phase<pg8::EpiSwiglu, pg8::StaticOrder, true, true>(c.lds, g, So, E, c.tid); }
        SEAM(base + 10);
        if (IN(base + 11)) { CTX(); pg8::Gemm g{WSP(bf16, WS_P), (const bf16*)(c.ws + WS_W2 + (size_t)(2 * L + 1) * SZ_W2), S_, D_, DFF}; pg8::StaticOrder So; So.init(S_, D_, c.G, c.bid);
            pg8::EpiStore E{WSP(bf16, WS_Y), D_}; pg8::gemm_phase<pg8::EpiStore, pg8::StaticOrder, true, true>(c.lds, g, So, E, c.tid); }
        SEAM(base + 11);
        if (IN(base + 12)) { CTX(); const float* ng = c.norm_g + (size_t)L * 6 * D_; phase_rowpass(c, ng + 5 * D_, 0.5f, (L + 1 < DEPTH) ? ng + 6 * D_ : nullptr); }
        if (L + 1 < DEPTH) SEAM(base + 12);
    }
#undef IN
#undef SEAM
}

extern "C" void kernel_launch(void* const* d_in, const int* in_sizes, int n_in, void* d_out, int out_size, void* d_ws, size_t ws_size, hipStream_t stream) {
    static int grid = 0;
    if (grid == 0) {
        if (n_in != 16 || in_sizes[0] != S_ * D_ || out_size != S_ * D_ || ws_size < WS_END) { fprintf(stderr, "kernel_launch: unexpected shapes/workspace (n_in %d, in0 %d, out %d, ws %zu < %zu)\n", n_in, n_in > 0 ? in_sizes[0] : -1, out_size, ws_size, (size_t)WS_END); grid = -1; return; }
        int dev = 0, cus = 0;
        if (hipGetDevice(&dev) != hipSuccess || hipDeviceGetAttribute(&cus, hipDeviceAttributeMultiprocessorCount, dev) != hipSuccess) { grid = -1; return; }
        if (hipFuncSetAttribute((const void*)mk_fwd, hipFuncAttributeMaxDynamicSharedMemorySize, LDS_BYTES) != hipSuccess) { fprintf(stderr, "kernel_launch: hipFuncSetAttribute failed\n"); grid = -1; return; }
        int per_cu = 0;
        if (hipOccupancyMaxActiveBlocksPerMultiprocessor(&per_cu, (const void*)mk_fwd, NTHREADS, LDS_BYTES) != hipSuccess || per_cu < 1) fprintf(stderr, "kernel_launch: occupancy query says %d\n", per_cu);
        (void)hipGetLastError();
        grid = cus;
    }
    if (grid < 0) return;
    (void)hipMemsetAsync((char*)d_ws + WS_CTL, 0, CTL_ZERO_BYTES, stream);
    Args a{};
    for (int i = 0; i < 16; ++i) a.in[i] = (const float*)d_in[i];
    a.out = (float*)d_out; a.ws = (unsigned char*)d_ws;
#if MK_FUSED
    a.ph_lo = 0; a.ph_hi = N_PHASES;
    hipLaunchKernelGGL(mk_fwd, dim3(grid), dim3(NTHREADS), LDS_BYTES, stream, a);
#else
    for (int p = 0; p < N_PHASES; ++p) {
        a.ph_lo = p; a.ph_hi = p + 1;
        hipLaunchKernelGGL(mk_fwd, dim3(grid), dim3(NTHREADS), LDS_BYTES, stream, a);
    }
#endif
}
```

```cpp
#include <hip/hip_runtime.h>
#include <cstdio>
#include <cstdint>
namespace pg8 {
#define PG8_LAS __attribute__((address_space(3)))
typedef unsigned short bf16_t;
typedef short bf16x8 __attribute__((ext_vector_type(8)));
typedef float f32x4 __attribute__((ext_vector_type(4)));
typedef unsigned u32x4 __attribute__((ext_vector_type(4)));
constexpr int BM = 256, BK = 64, HALF = 128, HTB = HALF * BK * 2  , STAGE_BYTES = 8 * HTB, NXCD = 8, WGM = 8;

__host__ __device__ __forceinline__ int lds_byte(int r, int c) { const int st = (r >> 4) * 2 + (c >> 5), rr = r & 15, cc = c & 31, ob = rr * 64 + cc * 2; return st * 1024 + (ob ^ (((ob >> 9) & 1) << 5)); }
__host__ __device__ __forceinline__ void stage_rc(int b, int& R, int& C) { const int st = b / 1024, sb = b % 1024, swz = sb ^ (((sb >> 9) & 1) << 5); R = (st >> 1) * 16 + swz / 64; C = (st & 1) * 32 + (swz % 64) / 2; }
__host__ __device__ __forceinline__ int perm32(int rho) { const int n = rho >> 4, i = rho & 15; return 8 * (i >> 2) + 4 * n + (i & 3); }

struct Unit { int pm, pn; };
struct Gemm { const bf16_t* A; const bf16_t* Bt; int M, N, K; };

struct StaticOrder {
    int nM, nN, nwg, G, c;
    __host__ __device__ void init(int M, int N, int G_, int c_) { nM = M / BM; nN = N / BM; nwg = nM * nN; G = G_; c = c_; }
    __host__ __device__ bool next(int i, Unit& u) const {
        const long L = (long)i * G + c; if (L >= nwg) return false;
        int wgid = (int)L; { const int q = nwg / NXCD, r = nwg % NXCD, xcd = wgid % NXCD, off = wgid / NXCD; wgid = (xcd < r ? xcd * (q + 1) : r * (q + 1) + (xcd - r) * q) + off; }
        const int nig = WGM * nN, gid = wgid / nig, fm = gid * WGM, gsz = (nM - fm) < WGM ? (nM - fm) : WGM;
        u.pm = fm + ((wgid % nig) % gsz); u.pn = (wgid % nig) / gsz; return true;
    }
    __device__ __forceinline__ void a_ready(const Unit&) const {}
    __device__ __forceinline__ void done(const Unit&) const {}
};

__device__ __forceinline__ unsigned cvt_pk_bf16(float lo, float hi) { unsigned r; asm volatile("v_cvt_pk_bf16_f32 %0, %1, %2" : "=v"(r) : "v"(lo), "v"(hi)); return r; }
struct EpiStore {
    static constexpr bool PERM = true, AFTER_DRAIN = false;
    bf16_t* O; int ldc;
    __device__ __forceinline__ void operator()(const f32x4 (&acc)[2][2][4][2], const Unit& u, int wr, int wc, int fr, int fq) const {
        const int row0 = u.pm * BM + wr * 64 + fr, col0 = u.pn * BM + wc * 32 + 8 * fq;
#pragma unroll
        for (int ai = 0; ai < 2; ++ai)
#pragma unroll
            for (int m = 0; m < 4; ++m) { bf16_t* rowp = O + (size_t)(row0 + ai * HALF + m * 16) * ldc + col0;
#pragma unroll
                for (int bj = 0; bj < 2; ++bj) { const f32x4 v0 = acc[ai][bj][m][0], v1 = acc[ai][bj][m][1];
                    u32x4 w; w.x = cvt_pk_bf16(v0[0], v0[1]); w.y = cvt_pk_bf16(v0[2], v0[3]); w.z = cvt_pk_bf16(v1[0], v1[1]); w.w = cvt_pk_bf16(v1[2], v1[3]);
                    *(u32x4*)(rowp + bj * HALF) = w; } }
    }
};
__device__ __forceinline__ float silu_f(float a) { return a * __builtin_amdgcn_rcpf(1.0f + __expf(-a)); }
struct EpiSwiglu {
    static constexpr bool PERM = true, AFTER_DRAIN = false;
    bf16_t* O; int ldc;
    __device__ __forceinline__ void operator()(const f32x4 (&acc)[2][2][4][2], const Unit& u, int wr, int wc, int fr, int fq) const {
        const int row0 = u.pm * BM + wr * 64 + fr, col0 = u.pn * HALF + wc * 32 + 8 * fq;
#pragma unroll
        for (int ai = 0; ai < 2; ++ai)
#pragma unroll
            for (int m = 0; m < 4; ++m) { bf16_t* rowp = O + (size_t)(row0 + ai * HALF + m * 16) * ldc + col0;
                const f32x4 a0 = acc[ai][0][m][0], a1 = acc[ai][0][m][1], b0 = acc[ai][1][m][0], b1 = acc[ai][1][m][1];
                u32x4 w; w.x = cvt_pk_bf16(silu_f(a0[0]) * b0[0], silu_f(a0[1]) * b0[1]); w.y = cvt_pk_bf16(silu_f(a0[2]) * b0[2], silu_f(a0[3]) * b0[3]);
                w.z = cvt_pk_bf16(silu_f(a1[0]) * b1[0], silu_f(a1[1]) * b1[1]); w.w = cvt_pk_bf16(silu_f(a1[2]) * b1[2], silu_f(a1[3]) * b1[3]);
                *(u32x4*)rowp = w; }
    }
};

template <class Epi, class Sched, bool ALIGN_EPI = false, bool SP2 = false>
__device__ __forceinline__ void gemm_phase(PG8_LAS unsigned char* lds, const Gemm g, const Sched& S, const Epi& E, int tid_in) {
    int tid_l = tid_in; asm volatile("" : "+v"(tid_l));
    const int tid = tid_l, wid = __builtin_amdgcn_readfirstlane(tid >> 6), lane = tid & 63, wr = wid >> 2, wc = wid & 3, fr = lane & 15, fq = lane >> 4;
    const int K = g.K, nt = K / BK;
    unsigned voffA[2], voffB[2];
#pragma unroll
    for (int i = 0; i < 2; ++i) { int R, C; stage_rc(tid * 16 + i * 8192, R, C); const int Rb = Epi::PERM ? ((R & ~31) + perm32(R & 31)) : R;
        voffA[i] = (unsigned)(R * K + C) * 2u; voffB[i] = (unsigned)(Rb * K + C) * 2u; }
    const size_t kstep = (size_t)(BK * 2);
    const size_t hstep = (size_t)HALF * K * 2;
    const size_t tstep = 2 * hstep;
    const unsigned ldsw = (unsigned)wid * 1024u;
    const int aoff = lds_byte(wr * 64 + fr, fq * 8), boff = lds_byte(wc * 32 + fr, fq * 8);
#define PG8_SA(b, h) (((b) * 2 + (h)) * HTB)
#define PG8_SB(b, h) ((4 + (b) * 2 + (h)) * HTB)
#define PG8_STAGE(bufoff, gbase, voff) do { _Pragma("unroll") for (int _i = 0; _i < 2; ++_i) \
        __builtin_amdgcn_global_load_lds((const unsigned*)((const char*)(gbase) + (voff)[_i]), (PG8_LAS unsigned*)(lds + (bufoff) + ldsw + _i * 8192), 16, 0, 0); } while (0)
#define PG8_LDA(dst, b, h) do { _Pragma("unroll") for (int m = 0; m < 4; ++m) _Pragma("unroll") for (int k = 0; k < 2; ++k) dst[m][k] = *(const PG8_LAS bf16x8*)(lds + PG8_SA(b, h) + aoff + m * 2048 + k * 1024); } while (0)
#define PG8_LDB(dst, b, h) do { _Pragma("unroll") for (int n = 0; n < 2; ++n) _Pragma("unroll") for (int k = 0; k < 2; ++k) dst[n][k] = *(const PG8_LAS bf16x8*)(lds + PG8_SB(b, h) + boff + n * 2048 + k * 1024); } while (0)
#define PG8_MMA(ai, bj, At, Bt) do { __builtin_amdgcn_s_setprio(1); _Pragma("unroll") for (int m = 0; m < 4; ++m) _Pragma("unroll") for (int n = 0; n < 2; ++n) _Pragma("unroll") for (int k = 0; k < 2; ++k) \
        acc[ai][bj][m][n] = __builtin_amdgcn_mfma_f32_16x16x32_bf16(Bt[n][k], At[m][k], acc[ai][bj][m][n], 0, 0, 0); __builtin_amdgcn_s_setprio(0); } while (0)
#define PG8_WAIT_V(n) asm volatile("s_waitcnt vmcnt(" #n ")" ::: "memory")
#define PG8_WAIT_L(n) asm volatile("s_waitcnt lgkmcnt(" #n ")" ::: "memory")
#define PG8_BAR __builtin_amdgcn_s_barrier()
#define PG8_SCHED __builtin_amdgcn_sched_barrier(0)
    Unit cur, nxt; int ui = 0;
    if (!S.next(0, cur)) return;
    f32x4 acc[2][2][4][2];
#pragma unroll
    for (int a = 0; a < 2; ++a)
#pragma unroll
        for (int b = 0; b < 2; ++b)
#pragma unroll
            for (int m = 0; m < 4; ++m)
#pragma unroll
                for (int n = 0; n < 2; ++n) acc[a][b][m][n] = (f32x4){0.f, 0.f, 0.f, 0.f};
    bf16x8 At[4][2], B0[2][2], B1[2][2];
    const char* cA = (const char*)g.A + (size_t)cur.pm * tstep; const char* cB = (const char*)g.Bt + (size_t)cur.pn * tstep;
    S.a_ready(cur);
    if constexpr (SP2) {
        PG8_STAGE(PG8_SB(0, 0), cB, voffB); PG8_STAGE(PG8_SB(0, 1), cB + hstep, voffB); PG8_STAGE(PG8_SA(0, 0), cA, voffA); PG8_STAGE(PG8_SA(0, 1), cA + hstep, voffA);
        if (wr == 1) PG8_BAR;
        PG8_WAIT_V(2); PG8_BAR;
        PG8_STAGE(PG8_SB(1, 0), cB + kstep, voffB); PG8_STAGE(PG8_SA(1, 0), cA + kstep, voffA); PG8_STAGE(PG8_SB(1, 1), cB + hstep + kstep, voffB);
        PG8_WAIT_V(6); PG8_BAR;
    } else {
        PG8_STAGE(PG8_SB(0, 0), cB, voffB); PG8_STAGE(PG8_SA(0, 0), cA, voffA); PG8_STAGE(PG8_SB(0, 1), cB + hstep, voffB); PG8_STAGE(PG8_SA(0, 1), cA + hstep, voffA);
        if (wr == 1) PG8_BAR;
        PG8_WAIT_V(4); PG8_BAR;
        PG8_STAGE(PG8_SB(1, 0), cB + kstep, voffB); PG8_STAGE(PG8_SA(1, 0), cA + kstep, voffA); PG8_STAGE(PG8_SB(1, 1), cB + hstep + kstep, voffB);
        PG8_WAIT_V(6); PG8_BAR;
    }
    for (;;) {
        const bool has_next = S.next(ui + 1, nxt);
        const char* nA = has_next ? (const char*)g.A + (size_t)nxt.pm * tstep : cA; const char* nB = has_next ? (const char*)g.Bt + (size_t)nxt.pn * tstep : cB;
        for (int t = 0; t < nt; t += 2) {
            const bool last = (t == nt - 2);
            const char* a1 = cA + (size_t)(t + 1) * kstep;
            const char* a2 = last ? nA : cA + (size_t)(t + 2) * kstep; const char* b2 = last ? nB : cB + (size_t)(t + 2) * kstep;
            const char* a3 = a2 + kstep; const char* b3 = b2 + kstep;
            if (last && has_next) S.a_ready(nxt);
            if constexpr (SP2) {
            PG8_LDB(B0, 0, 0); PG8_LDB(B1, 0, 1); PG8_SCHED; PG8_LDA(At, 0, 0); PG8_STAGE(PG8_SA(1, 1), a1 + hstep, voffA);
            PG8_WAIT_V(8); PG8_WAIT_L(0); PG8_BAR; PG8_MMA(0, 0, At, B0); PG8_MMA(0, 1, At, B1); PG8_BAR; PG8_SCHED;
            PG8_LDA(At, 0, 1); PG8_STAGE(PG8_SB(0, 0), b2, voffB); PG8_STAGE(PG8_SB(0, 1), b2 + hstep, voffB); PG8_STAGE(PG8_SA(0, 0), a2, voffA);
            PG8_WAIT_V(8); PG8_WAIT_L(0); PG8_BAR; PG8_MMA(1, 0, At, B0); PG8_MMA(1, 1, At, B1); PG8_BAR; PG8_SCHED;
            PG8_LDB(B0, 1, 0); PG8_LDB(B1, 1, 1); PG8_SCHED; PG8_LDA(At, 1, 0); PG8_STAGE(PG8_SA(0, 1), a2 + hstep, voffA);
            PG8_WAIT_V(8); PG8_WAIT_L(0); PG8_BAR; PG8_MMA(0, 0, At, B0); PG8_MMA(0, 1, At, B1); PG8_BAR; PG8_SCHED;
            PG8_LDA(At, 1, 1); PG8_STAGE(PG8_SB(1, 0), b3, voffB); PG8_STAGE(PG8_SB(1, 1), b3 + hstep, voffB); PG8_STAGE(PG8_SA(1, 0), a3, voffA);
            PG8_WAIT_V(8); PG8_WAIT_L(0); PG8_BAR; PG8_MMA(1, 0, At, B0); PG8_MMA(1, 1, At, B1); PG8_BAR; PG8_SCHED;
            } else {
            PG8_LDB(B0, 0, 0); PG8_SCHED; PG8_LDA(At, 0, 0); PG8_STAGE(PG8_SA(1, 1), a1 + hstep, voffA);
            PG8_WAIT_L(8); PG8_BAR; PG8_WAIT_L(0); PG8_MMA(0, 0, At, B0); PG8_BAR; PG8_SCHED;
            PG8_LDB(B1, 0, 1); PG8_STAGE(PG8_SB(0, 0), b2, voffB);
            PG8_BAR; PG8_WAIT_L(0); PG8_MMA(0, 1, At, B1); PG8_BAR;
            PG8_LDA(At, 0, 1); PG8_STAGE(PG8_SA(0, 0), a2, voffA);
            PG8_BAR; PG8_WAIT_L(0); PG8_MMA(1, 0, At, B0); PG8_BAR; PG8_SCHED;
            PG8_STAGE(PG8_SB(0, 1), b2 + hstep, voffB);
            PG8_WAIT_V(6); PG8_BAR; PG8_MMA(1, 1, At, B1); PG8_BAR;
            PG8_LDB(B0, 1, 0); PG8_SCHED; PG8_LDA(At, 1, 0); PG8_STAGE(PG8_SA(0, 1), a2 + hstep, voffA);
            PG8_WAIT_L(8); PG8_BAR; PG8_WAIT_L(0); PG8_MMA(0, 0, At, B0); PG8_BAR; PG8_SCHED;
            PG8_LDB(B1, 1, 1); PG8_STAGE(PG8_SB(1, 0), b3, voffB);
            PG8_BAR; PG8_WAIT_L(0); PG8_MMA(0, 1, At, B1); PG8_BAR;
            PG8_LDA(At, 1, 1); PG8_STAGE(PG8_SA(1, 0), a3, voffA);
            PG8_BAR; PG8_WAIT_L(0); PG8_MMA(1, 0, At, B0); PG8_BAR; PG8_SCHED;
            PG8_STAGE(PG8_SB(1, 1), b3 + hstep, voffB);
            PG8_WAIT_V(6); PG8_BAR; PG8_MMA(1, 1, At, B1); PG8_BAR;
            }
        }
        if constexpr (ALIGN_EPI) { if (wr == 0) PG8_BAR; }
        if constexpr (!Epi::AFTER_DRAIN) { E(acc, cur, wr, wc, fr, fq); S.done(cur); }
        if (!has_next) break;
#pragma unroll
        for (int a = 0; a < 2; ++a)
#pragma unroll
            for (int b = 0; b < 2; ++b)
#pragma unroll
                for (int m = 0; m < 4; ++m)
#pragma unroll
                    for (int n = 0; n < 2; ++n) acc[a][b][m][n] = (f32x4){0.f, 0.f, 0.f, 0.f};
        cur = nxt; cA = nA; cB = nB; ++ui;
        if constexpr (ALIGN_EPI) { if (wr == 1) PG8_BAR; }
    }
    PG8_WAIT_V(0);
    if constexpr (!ALIGN_EPI) { if (wr == 0) PG8_BAR; }
    PG8_BAR;
    if constexpr (Epi::AFTER_DRAIN) { E.fused(acc, cur, wr, wc, fr, fq, lds, wid, lane); S.done(cur); }
#undef PG8_SA
#undef PG8_SB
#undef PG8_STAGE
#undef PG8_LDA
#undef PG8_LDB
#undef PG8_MMA
#undef PG8_WAIT_V
#undef PG8_WAIT_L
#undef PG8_BAR
#undef PG8_SCHED
}
}

constexpr int S_ = 8192, D_ = 2048, DFF = 5504, DEPTH = 4;
constexpr int AB_IN = 9216, AB_OUT = 3072, C_IN = 5168, C_INP = 5376, C_OUT = 2048;
constexpr int NUP = 2 * DFF;
constexpr float NORM_EPS = 1e-6f;
constexpr int NWAVES = 8, NTHREADS = 512;
#ifndef MK_FUSED
#define MK_FUSED 1
#endif
constexpr int N_PHASES = 1 + 13 * DEPTH;

constexpr size_t MiB = 1u << 20;
constexpr size_t WS_CTL = 0, CTL_ZERO_BYTES = 1 * MiB;
constexpr size_t SZ_W13 = (size_t)NUP * D_ * 2, SZ_W2 = (size_t)D_ * DFF * 2, SZ_ABIN = (size_t)AB_IN * D_ * 2, SZ_ABOUT = (size_t)D_ * AB_OUT * 2, SZ_CIN = (size_t)C_INP * D_ * 2, SZ_COUT = (size_t)D_ * C_OUT * 2;
constexpr size_t WS_W13 = 2 * MiB, WS_W2 = WS_W13 + 8 * SZ_W13, WS_ABIN = WS_W2 + 8 * SZ_W2, WS_ABOUT = WS_ABIN + 2 * SZ_ABIN, WS_CIN = WS_ABOUT + 2 * SZ_ABOUT, WS_COUT = WS_CIN + 2 * SZ_CIN;
constexpr size_t WS_H = WS_COUT + 2 * SZ_COUT;
constexpr size_t WS_Y = WS_H + (size_t)S_ * D_ * 2;
constexpr size_t WS_CAT = WS_Y + (size_t)S_ * D_ * 2;
constexpr size_t WS_P = WS_CAT + (size_t)S_ * AB_OUT * 2;
constexpr size_t WS_KV = WS_P + (size_t)S_ * AB_IN * 2;
constexpr size_t WS_PREV = WS_KV + (size_t)8 * 64 * 128 * 256 * 4;
constexpr size_t WS_CK = WS_PREV + (size_t)8 * 64 * 128 * 256 * 4;
constexpr size_t WS_CV = WS_CK + (size_t)4 * 512 * 128 * 4;
constexpr size_t WS_OACC = WS_CV + (size_t)4 * 512 * 128 * 4;
constexpr size_t WS_BM = WS_OACC + (size_t)S_ * C_OUT * 2;
constexpr size_t WS_DST = WS_BM + (size_t)4 * S_ * 4 * 4;
constexpr size_t WS_CW1 = WS_DST + ((size_t)S_ * 1024 + (size_t)S_ * 16) * 4;
constexpr size_t WS_CW2 = WS_CW1 + (size_t)4 * 256 * 4096 * 2;
constexpr size_t WS_CB1 = WS_CW2 + (size_t)4 * 128 * 256 * 2;
constexpr size_t WS_END = WS_CB1 + (size_t)4 * 256 * 4;
static_assert(WS_W13 % 256 == 0 && WS_W2 % 256 == 0 && WS_H % 256 == 0 && WS_P % 256 == 0 && WS_KV % 256 == 0, "alignment");

constexpr int CW_BAR = 4096;
constexpr int RING_BYTES = 131072, MISC_OFF = RING_BYTES + 320, LDS_BYTES = 147456;

#define GAS __attribute__((address_space(1)))
#define LAS __attribute__((address_space(3)))
typedef unsigned short bf16;
typedef unsigned v4u __attribute__((ext_vector_type(4)));
typedef unsigned v2u __attribute__((ext_vector_type(2)));
typedef float f32x4 __attribute__((ext_vector_type(4)));
typedef float f32x2 __attribute__((ext_vector_type(2)));
#define LDS_WAIT() asm volatile("s_waitcnt lgkmcnt(0)" ::: "memory")
__device__ __forceinline__ unsigned f2bf(float f) { unsigned u = __builtin_bit_cast(unsigned, f); return (u + 0x7fffu + ((u >> 16) & 1u)) >> 16; }
__device__ __forceinline__ unsigned pk2(float lo, float hi) { return f2bf(lo) | (f2bf(hi) << 16); }
__device__ __forceinline__ float bflo(unsigned w) { return __builtin_bit_cast(float, w << 16); }
__device__ __forceinline__ float bfhi(unsigned w) { return __builtin_bit_cast(float, w & 0xffff0000u); }
__device__ __forceinline__ float bf2f(bf16 b) { return __builtin_bit_cast(float, (unsigned)b << 16); }
__device__ __forceinline__ float wave_sum(float v) {
#pragma unroll
    for (int o = 1; o < 64; o <<= 1) v += __shfl_xor(v, o);
    return v;
}
__device__ __forceinline__ float wave_max(float v) {
#pragma unroll
    for (int o = 1; o < 64; o <<= 1) v = fmaxf(v, __shfl_xor(v, o));
    return v;
}
__device__ __forceinline__ float rdlane(float v, int j) { return __builtin_bit_cast(float, __builtin_amdgcn_readlane(__builtin_bit_cast(int, v), j)); }

#define XB_TMO      128
#define XB_XCNT(j)  (256  + 64 * (j))
#define XB_XSUB(j)  (1280 + 64 * (j))
#define XB_XGEN(j)  (2304 + 64 * (j))
#define XB_TOP      3328
#define XB_TOPGEN   3392
#define XCD_BAR_WORDS 3456
#define XB_SPIN_CAP (1u << 18)

__device__ __forceinline__ unsigned xb_ld(unsigned* p)              { return __hip_atomic_load(p, __ATOMIC_RELAXED, __HIP_MEMORY_SCOPE_AGENT); }
__device__ __forceinline__ unsigned xb_add(unsigned* p, unsigned v) { return __hip_atomic_fetch_add(p, v, __ATOMIC_RELAXED, __HIP_MEMORY_SCOPE_AGENT); }
__device__ __forceinline__ unsigned xb_xcc_id() { return (unsigned)__builtin_amdgcn_s_getreg((3 << 11) | 20) & 0xFu; }
#define XB_SPIN(cond, bar) do { unsigned _sp = 0; while (cond) { __builtin_amdgcn_s_sleep(1); \
    if ((++_sp & 255u) == 0u) { if (xb_ld(&(bar)[XB_TMO])) break; if (_sp > XB_SPIN_CAP) { atomicAdd(&(bar)[XB_TMO], 1u); break; } } } } while (0)

struct XcdBarrier {
    unsigned* bar; unsigned x;
    volatile LAS unsigned* st;
};

__device__ __forceinline__ XcdBarrier xcd_barrier_post(unsigned* bar, volatile LAS unsigned* st) {
    XcdBarrier b; b.bar = bar; b.x = xb_xcc_id(); b.st = st;
    if (threadIdx.x == 0) (void)xb_add(&bar[XB_XCNT(b.x)], 1u);
    return b;
}
__device__ __forceinline__ void xcd_barrier_complete(unsigned* bar, unsigned x, unsigned& nloc, unsigned& nx) {
    const unsigned G = gridDim.x * gridDim.y * gridDim.z;
    unsigned sum, cnt, mine, sp = 0u;
    for (;;) {
        sum = 0u; cnt = 0u; mine = 0u;
#pragma unroll
        for (unsigned j = 0; j < 16; ++j) { const unsigned c = xb_ld(&bar[XB_XCNT(j)]); sum += c; cnt += (c > 0u) ? 1u : 0u; mine = (j == x) ? c : mine; }
        if (sum == G) break;
        __builtin_amdgcn_s_sleep(1);
        if ((++sp & 255u) == 0u) { if (xb_ld(&bar[XB_TMO])) break; if (sp > XB_SPIN_CAP) { atomicAdd(&bar[XB_TMO], 1u); break; } }
    }
    nloc = mine > 0u ? mine : 1u; nx = cnt > 0u ? cnt : 1u;
}

__device__ __forceinline__ void xcd_barrier(const XcdBarrier& b) {
    asm volatile("s_waitcnt vmcnt(0)" ::: "memory");
    __syncthreads();
    if (threadIdx.x == 0) {
        unsigned* bar = b.bar;
        __builtin_amdgcn_s_waitcnt(0);
        unsigned nloc = b.st[0], nx = b.st[1];
        if (nloc == 0u) { xcd_barrier_complete(bar, b.x, nloc, nx); b.st[0] = nloc; b.st[1] = nx; }
        const unsigned old = xb_add(&bar[XB_XSUB(b.x)], 1u);
        const unsigned gen = old / nloc;
        if (old + 1u == (gen + 1u) * nloc) {
            __builtin_amdgcn_fence(__ATOMIC_RELEASE, "agent");
            asm volatile("s_waitcnt vmcnt(0)" ::: "memory");
            const unsigned og = xb_add(&bar[XB_TOP], 1u);
            const unsigned tg = og / nx;
            if (og + 1u == (tg + 1u) * nx) xb_add(&bar[XB_TOPGEN], 1u);
            else XB_SPIN(xb_ld(&bar[XB_TOPGEN]) == tg, bar);
            __builtin_amdgcn_fence(__ATOMIC_ACQUIRE, "agent");
            xb_add(&bar[XB_XGEN(b.x)], 1u);
            asm volatile("s_waitcnt vmcnt(0)" ::: "memory");
        } else {
            XB_SPIN(xb_ld(&bar[XB_XGEN(b.x)]) == gen, bar);
            __builtin_amdgcn_fence(__ATOMIC_ACQUIRE, "agent");
            asm volatile("s_waitcnt vmcnt(0)" ::: "memory");
        }
    }
    __syncthreads();
}

struct Ctx {
    const float* x; const int* pos; const float* norm_g; const float *w1, *w3, *w2, *ab_in, *ab_out, *c_in, *c_out, *ck_w1, *ck_w2, *cv_w1, *cv_w2, *pe_k, *pe_v;
    float* out; unsigned char* ws;
    int tid, lane, wave, bid, G, gw, NGW;
    LAS unsigned char* lds;
};

__device__ __forceinline__ void transpose_item(const float* W, int K, int N, bf16* WT, int dst_row0, LAS float* scr, int k0, int n0, int lane) {
#pragma unroll 8
    for (int i = 0; i < 32; ++i) { const int kk = 2 * i + (lane >> 5); const int n = n0 + (lane & 31); scr[kk * 33 + (lane & 31)] = (n < N) ? W[(size_t)(k0 + kk) * N + n] : 0.f; }
    LDS_WAIT();
    const int c = lane & 7;
#pragma unroll
    for (int j = 0; j < 4; ++j) { const int nl = (lane >> 3) + 8 * j; const LAS float* s = scr + (8 * c) * 33 + nl;
        v4u o; o.x = pk2(s[0 * 33], s[1 * 33]); o.y = pk2(s[2 * 33], s[3 * 33]); o.z = pk2(s[4 * 33], s[5 * 33]); o.w = pk2(s[6 * 33], s[7 * 33]);
        *(v4u*)(WT + (size_t)(dst_row0 + nl) * K + k0 + 8 * c) = o; }
    LDS_WAIT();
}
__device__ __forceinline__ void phase_prologue(const Ctx& c) {
    LAS float* scr = (LAS float*)(c.lds + c.wave * 16384);
    constexpr int I13 = (D_ / 64) * (DFF / 32), I2 = (DFF / 64) * (D_ / 32), IABI = (D_ / 64) * (AB_IN / 32), IABO = (AB_OUT / 64) * (D_ / 32), ICI = (D_ / 64) * (C_INP / 32), ICO = (C_OUT / 64) * (D_ / 32);
    constexpr int NFFN = 24 * I13;
    static_assert(I13 == I2, "ffn item counts");
    constexpr int NITEMS = NFFN + 2 * (IABI + IABO + ICI + ICO);
    for (int it = c.gw; it < NITEMS; it += c.NGW) {
        if (it < NFFN) {
            const int mat = it / I13, r = it % I13, lf = mat / 3, which = mat % 3;
            if (which < 2) { const int nblk = DFF / 32, kb = r / nblk, nb = r % nblk, n0 = 32 * nb;
                const float* W = (which == 0 ? c.w1 : c.w3) + (size_t)lf * D_ * DFF;
                bf16* WT = (bf16*)(c.ws + WS_W13 + (size_t)lf * SZ_W13);
                transpose_item(W, D_, DFF, WT, 256 * (n0 / 128) + (n0 % 128) + 128 * which, scr, 64 * kb, n0, c.lane);
            } else { const int nblk = D_ / 32, kb = r / nblk, nb = r % nblk;
                transpose_item(c.w2 + (size_t)lf * DFF * D_, DFF, D_, (bf16*)(c.ws + WS_W2 + (size_t)lf * SZ_W2), 32 * nb, scr, 64 * kb, 32 * nb, c.lane); }
            continue;
        }
        int r = it - NFFN;
        const int j = r / (IABI + IABO + ICI + ICO); r = r % (IABI + IABO + ICI + ICO);
        if (r < IABI) { const int nblk = AB_IN / 32, kb = r / nblk, nb = r % nblk; transpose_item(c.ab_in + (size_t)j * D_ * AB_IN, D_, AB_IN, (bf16*)(c.ws + WS_ABIN + (size_t)j * SZ_ABIN), 32 * nb, scr, 64 * kb, 32 * nb, c.lane); continue; } r -= IABI;
        if (r < IABO) { const int nblk = D_ / 32, kb = r / nblk, nb = r % nblk; transpose_item(c.ab_out + (size_t)j * AB_OUT * D_, AB_OUT, D_, (bf16*)(c.ws + WS_ABOUT + (size_t)j * SZ_ABOUT), 32 * nb, scr, 64 * kb, 32 * nb, c.lane); continue; } r -= IABO;
        if (r < ICI) { const int nblk = C_INP / 32, kb = r / nblk, nb = r % nblk; transpose_item(c.c_in + (size_t)j * D_ * C_IN, D_, C_IN, (bf16*)(c.ws + WS_CIN + (size_t)j * SZ_CIN), 32 * nb, scr, 64 * kb, 32 * nb, c.lane); continue; } r -= ICI;
        { const int nblk = D_ / 32, kb = r / nblk, nb = r % nblk; transpose_item(c.c_out + (size_t)j * C_OUT * D_, C_OUT, D_, (bf16*)(c.ws + WS_COUT + (size_t)j * SZ_COUT), 32 * nb, scr, 64 * kb, 32 * nb, c.lane); }
    }
    for (int it = c.gw; it < 4 * 512 + 4 * 16 + 4 * 64; it += c.NGW) {
        if (it < 2048) { const int mt = it >> 9, r = it & 511, kb = r >> 3, nb = r & 7;
            transpose_item(((mt & 1) ? c.cv_w1 : c.ck_w1) + (size_t)(mt >> 1) * 4096 * 256, 4096, 256, (bf16*)(c.ws + WS_CW1) + (size_t)mt * 256 * 4096, 32 * nb, scr, 64 * kb, 32 * nb, c.lane); }
        else if (it < 2048 + 64) { const int r0 = it - 2048, mt = r0 >> 4, r = r0 & 15, kb = r >> 2, nb = r & 3;
            transpose_item(((mt & 1) ? c.cv_w2 : c.ck_w2) + (size_t)(mt >> 1) * 256 * 128, 256, 128, (bf16*)(c.ws + WS_CW2) + (size_t)mt * 128 * 256, 32 * nb, scr, 64 * kb, 32 * nb, c.lane); }
        else { const int r0 = it - 2048 - 64, mt = r0 >> 6, jq = r0 & 63;
            const float* w1 = ((mt & 1) ? c.cv_w1 : c.ck_w1) + (size_t)(mt >> 1) * 4096 * 256 + 4 * jq; const float* pe = ((mt & 1) ? c.pe_v : c.pe_k) + (size_t)(mt >> 1) * 4096;
            f32x4 a = (f32x4){0.f, 0.f, 0.f, 0.f};
#pragma unroll 4
            for (int i = 0; i < 64; ++i) { const int k = c.lane + 64 * i; a += *(const f32x4*)(w1 + (size_t)k * 256) * pe[k]; }
            a.x = wave_sum(a.x); a.y = wave_sum(a.y); a.z = wave_sum(a.z); a.w = wave_sum(a.w);
            if (c.lane == 0) *(f32x4*)((float*)(c.ws + WS_CB1) + mt * 256 + 4 * jq) = a; }
    }
    bf16* H = (bf16*)(c.ws + WS_H);
    for (int row = c.gw; row < S_; row += c.NGW) {
        const f32x4* xr = (const f32x4*)(c.x + (size_t)row * D_) + c.lane; f32x4* orow = (f32x4*)(c.out + (size_t)row * D_) + c.lane;
        f32x4 v[8]; float ss = 0.f;
#pragma unroll
        for (int j = 0; j < 8; ++j) { v[j] = xr[64 * j]; ss += (v[j].x * v[j].x + v[j].y * v[j].y) + (v[j].z * v[j].z + v[j].w * v[j].w); }
        const float rstd = 1.0f / sqrtf(wave_sum(ss) * (1.0f / D_) + NORM_EPS);
        v2u* h8 = (v2u*)(H + (size_t)row * D_) + c.lane;
#pragma unroll
        for (int j = 0; j < 8; ++j) { orow[64 * j] = v[j]; const f32x4 g = ((const f32x4*)c.norm_g)[c.lane + 64 * j];
            v2u o; o.x = pk2(v[j].x * rstd * g.x, v[j].y * rstd * g.y); o.y = pk2(v[j].z * rstd * g.z, v[j].w * rstd * g.w); h8[64 * j] = o; }
    }
}

__device__ __forceinline__ void phase_rowpass(const Ctx& c, const float* gpost, float coef, const float* gnext) {
    const bf16* Y = (const bf16*)(c.ws + WS_Y); bf16* H = (bf16*)(c.ws + WS_H);
    for (int row = c.gw; row < S_; row += c.NGW) {
        f32x4* xr = (f32x4*)(c.out + (size_t)row * D_) + c.lane; const v2u* yr = (const v2u*)(Y + (size_t)row * D_) + c.lane;
        f32x4 xv[8], yv[8]; float ss = 0.f;
#pragma unroll
        for (int j = 0; j < 8; ++j) { xv[j] = xr[64 * j]; const v2u w = yr[64 * j]; yv[j] = (f32x4){bflo(w.x), bfhi(w.x), bflo(w.y), bfhi(w.y)};
            ss += (yv[j].x * yv[j].x + yv[j].y * yv[j].y) + (yv[j].z * yv[j].z + yv[j].w * yv[j].w); }
        const float rstd = coef / sqrtf(wave_sum(ss) * (1.0f / D_) + NORM_EPS);
        float ss2 = 0.f;
#pragma unroll
        for (int j = 0; j < 8; ++j) { const f32x4 g = ((const f32x4*)gpost)[c.lane + 64 * j]; xv[j] = xv[j] + yv[j] * rstd * g; xr[64 * j] = xv[j];
            ss2 += (xv[j].x * xv[j].x + xv[j].y * xv[j].y) + (xv[j].z * xv[j].z + xv[j].w * xv[j].w); }
        if (gnext) {
            const float rstd2 = 1.0f / sqrtf(wave_sum(ss2) * (1.0f / D_) + NORM_EPS);
            v2u* h8 = (v2u*)(H + (size_t)row * D_) + c.lane;
#pragma unroll
            for (int j = 0; j < 8; ++j) { const f32x4 g = ((const f32x4*)gnext)[c.lane + 64 * j];
                v2u o; o.x = pk2(xv[j].x * rstd2 * g.x, xv[j].y * rstd2 * g.y); o.y = pk2(xv[j].z * rstd2 * g.z, xv[j].w * rstd2 * g.w); h8[64 * j] = o; }
        }
    }
}

__device__ __forceinline__ void sincos_ang(float ang, float& sn, float& cs) {
    double r = (double)ang * 0.15915494309189535; r -= floor(r); const float rf = (float)r;
    sn = __builtin_amdgcn_sinf(rf); cs = __builtin_amdgcn_cosf(rf);
}
__device__ __forceinline__ void rope_pair(bf16* p, int half, float sn, float cs) {
    const float x1 = bf2f(p[0]), x2 = bf2f(p[half]);
    p[0] = (bf16)f2bf(x1 * cs - x2 * sn); p[half] = (bf16)f2bf(x2 * cs + x1 * sn);
}
constexpr float LOG2_RET_BASE = 13.287712379549449f, LOG2_ROPE_THETA = 18.931568569324174f;
__device__ __forceinline__ void phase_rope_even(const Ctx& c) {
    bf16* P = (bf16*)(c.ws + WS_P);
    for (int t = c.gw; t < S_; t += c.NGW) {
        const float pos = (float)c.pos[t]; bf16* row = P + (size_t)t * AB_IN;
        { float sn, cs; sincos_ang(pos * exp2f(-(float)c.lane * (1.0f / 64.0f) * LOG2_RET_BASE), sn, cs);
#pragma unroll 4
          for (int cb = 0; cb < 16; ++cb) rope_pair(row + (cb >> 3) * 1024 + (cb & 7) * 128 + c.lane, 64, sn, cs); }
        { const int i = c.lane & 15; float sn, cs; sincos_ang(pos * exp2f(-(float)i * (1.0f / 16.0f) * LOG2_ROPE_THETA), sn, cs);
#pragma unroll
          for (int j = 0; j < 4; ++j) { const int cb = (c.lane >> 4) + 4 * j; rope_pair(row + 6144 + (cb >> 3) * 1024 + (cb & 7) * 128 + i, 16, sn, cs); } }
    }
}
__device__ __forceinline__ void phase_rope_odd(const Ctx& c) {
    bf16* P = (bf16*)(c.ws + WS_P);
    for (int t = c.gw; t < S_; t += c.NGW) {
        const float pos = (float)c.pos[t]; bf16* row = P + (size_t)t * C_INP;
        const int i = c.lane & 15; float sn, cs; sincos_ang(pos * exp2f(-(float)i * (1.0f / 16.0f) * LOG2_ROPE_THETA), sn, cs);
#pragma unroll
        for (int j = 0; j < 7; ++j) { const int cb = (c.lane >> 4) + 4 * j;
            const int col = cb < 16 ? cb * 128 : (cb < 20 ? 2048 + (cb - 16) * 128 : (cb < 24 ? 3072 + (cb - 20) * 128 : 4096 + (cb - 24) * 128));
            rope_pair(row + col + i, 16, sn, cs); }
    }
}

__device__ __forceinline__ float ret_log_gamma(int h) { const float x = __builtin_amdgcn_exp2f(-5.0f - (float)h);
    return -x * (1.0f + x * (0.5f + x * ((1.0f / 3.0f) + x * (0.25f + x * (0.2f + x * ((1.0f / 6.0f) + x * (1.0f / 7.0f))))))); }
constexpr float RET_SCALE = 0.08838834764831845f;
constexpr float ATT_C2 = 0.08838834764831845f * 1.4426950408889634f;

__device__ __forceinline__ float gelu_tanh(float x) { const float u = 0.7978845608028654f * (x + 0.044715f * x * x * x); const float t = 1.0f - 2.0f / (1.0f + __expf(2.0f * u)); return 0.5f * x * (1.0f + t); }
typedef short bf16x8 __attribute__((ext_vector_type(8)));
typedef short s16x4 __attribute__((ext_vector_type(4)));
__device__ __forceinline__ s16x4 vtr(const LAS unsigned char* p) { return __builtin_bit_cast(s16x4, __builtin_amdgcn_ds_read_tr16_b64_v4i16((LAS s16x4*)p)); }
__device__ __forceinline__ f32x4 mfma16(bf16x8 a, bf16x8 b, f32x4 c) { return __builtin_amdgcn_mfma_f32_16x16x32_bf16(a, b, c, 0, 0, 0); }
__device__ __forceinline__ int off_b(int row, int ch) { return 256 * row + 16 * (ch ^ (((row & 3) << 2) | ((row >> 2) & 3))); }
__device__ __forceinline__ unsigned cvtpk(float lo, float hi) { unsigned r; asm volatile("v_cvt_pk_bf16_f32 %0, %1, %2" : "=v"(r) : "v"(lo), "v"(hi)); return r; }
struct LaneGeo { int qi, g4; int koff[4]; int voff[8]; };
__device__ __forceinline__ LaneGeo lane_geo(int lane) {
    LaneGeo G; G.qi = lane & 15; G.g4 = lane >> 4;
    const int kx = ((G.qi & 3) << 2) | (G.qi >> 2);
#pragma unroll
    for (int ks = 0; ks < 4; ++ks) G.koff[ks] = 256 * G.qi + 16 * ((4 * ks + G.g4) ^ kx);
    const int q = G.qi >> 2, p = G.qi & 3, vx = (q << 2) | G.g4;
#pragma unroll
    for (int db = 0; db < 8; ++db) G.voff[db] = 256 * (4 * G.g4 + q) + 16 * ((2 * db + (p >> 1)) ^ vx) + 8 * (p & 1);
    return G;
}
template <class RP> __device__ __forceinline__ void tile_dma(LAS unsigned char* Kb, LAS unsigned char* Vb, const RP& rp, int wave, int lane) {
#pragma unroll
    for (int i = 0; i < 2; ++i) { const int p = wave + 8 * i, row = 4 * p + (lane >> 4), ch = (lane & 15) ^ (((row & 3) << 2) | ((row >> 2) & 3)); const bf16 *kp = nullptr, *vp = nullptr; rp(row, kp, vp);
        __builtin_amdgcn_global_load_lds((const unsigned*)(kp + 8 * ch), (LAS unsigned*)(Kb + 1024 * p), 16, 0, 0);
        __builtin_amdgcn_global_load_lds((const unsigned*)(vp + 8 * ch), (LAS unsigned*)(Vb + 1024 * p), 16, 0, 0); }
}
#define TILE_SYNC() do { asm volatile("s_waitcnt vmcnt(0)" ::: "memory"); __syncthreads(); } while (0)
template <class MaskF> __device__ __forceinline__ void attn_scores(f32x4 (&s)[2][4], const LAS unsigned char* Kb, const LaneGeo& G, const bf16x8 (&qf)[2][4], bool need_mask, const MaskF& mask) {
#pragma unroll
    for (int kg = 0; kg < 4; ++kg) { s[0][kg] = (f32x4){0.f, 0.f, 0.f, 0.f}; s[1][kg] = (f32x4){0.f, 0.f, 0.f, 0.f};
#pragma unroll
        for (int ks = 0; ks < 4; ++ks) { const bf16x8 a = *(const LAS bf16x8*)(Kb + 4096 * kg + G.koff[ks]); s[0][kg] = mfma16(a, qf[0][ks], s[0][kg]); s[1][kg] = mfma16(a, qf[1][ks], s[1][kg]); }
        asm volatile("" ::: "memory"); }
#pragma unroll
    for (int qg = 0; qg < 2; ++qg)
#pragma unroll
        for (int kg = 0; kg < 4; ++kg)
#pragma unroll
            for (int r = 0; r < 4; ++r) { float v = s[qg][kg][r] * ATT_C2; if (need_mask && !mask(qg, 16 * kg + 4 * G.g4 + r)) v = -__builtin_inff(); s[qg][kg][r] = v; }
}
template <class MaskF> __device__ __forceinline__ void attn_tile(const LAS unsigned char* Kb, const LAS unsigned char* Vb, const LaneGeo& G, const bf16x8 (&qf)[2][4],
                                                                 float (&m)[2], float (&l)[2], f32x4 (&o)[2][8], bool need_mask, const MaskF& mask) {
    f32x4 s[2][4];
    attn_scores(s, Kb, G, qf, need_mask, mask);
    bf16x8 pb[2][2];
#pragma unroll
    for (int qg = 0; qg < 2; ++qg) {
        float mx = -__builtin_inff();
#pragma unroll
        for (int kg = 0; kg < 4; ++kg) mx = fmaxf(mx, fmaxf(fmaxf(s[qg][kg][0], s[qg][kg][1]), fmaxf(s[qg][kg][2], s[qg][kg][3])));
        mx = fmaxf(mx, __shfl_xor(mx, 16)); mx = fmaxf(mx, __shfl_xor(mx, 32));
        const float mn = fmaxf(m[qg], mx), alpha = __builtin_amdgcn_exp2f(m[qg] - mn); m[qg] = mn;
        float ps = 0.f;
#pragma unroll
        for (int kg = 0; kg < 4; ++kg)
#pragma unroll
            for (int r = 0; r < 4; ++r) { const float p = __builtin_amdgcn_exp2f(s[qg][kg][r] - mn); s[qg][kg][r] = p; ps += p; }
        l[qg] = l[qg] * alpha + ps;
#pragma unroll
        for (int db = 0; db < 8; ++db) o[qg][db] *= alpha;
#pragma unroll
        for (int k2 = 0; k2 < 2; ++k2) { v4u w; w.x = cvtpk(s[qg][2 * k2][0], s[qg][2 * k2][1]); w.y = cvtpk(s[qg][2 * k2][2], s[qg][2 * k2][3]);
            w.z = cvtpk(s[qg][2 * k2 + 1][0], s[qg][2 * k2 + 1][1]); w.w = cvtpk(s[qg][2 * k2 + 1][2], s[qg][2 * k2 + 1][3]); pb[qg][k2] = __builtin_bit_cast(bf16x8, w); }
    }
#pragma unroll
    for (int k2 = 0; k2 < 2; ++k2)
#pragma unroll
        for (int db = 0; db < 8; ++db) { const s16x4 lo = vtr(Vb + 8192 * k2 + G.voff[db]), hi = vtr(Vb + 8192 * k2 + 4096 + G.voff[db]);
            const bf16x8 vf = __builtin_shufflevector(lo, hi, 0, 1, 2, 3, 4, 5, 6, 7);
            o[0][db] = mfma16(vf, pb[0][k2], o[0][db]); o[1][db] = mfma16(vf, pb[1][k2], o[1][db]);
            if ((db & 3) == 3) asm volatile("" ::: "memory"); }
}
__device__ __forceinline__ float sigmoid_f(float x) { return 1.0f / (1.0f + __expf(-x)); }
constexpr int ATT_K0 = 0, ATT_K1 = 16384, ATT_V0 = 32768, ATT_V1 = 49152, ATT_X = 65536;

__device__ __forceinline__ void phase_compress(const Ctx& c, int jx) {
    const bf16* P = (const bf16*)(c.ws + WS_P);
    const int qi = c.lane & 15, g4 = c.lane >> 4;
    LAS unsigned char* Hs = c.lds;
    for (int u = c.bid; u < 256; u += c.G) {
        const int tensor = u >> 7, g = (u >> 5) & 3, n0 = 16 * (u & 31), mt = jx * 2 + tensor;
        const bf16* W1T = (const bf16*)(c.ws + WS_CW1) + (size_t)mt * 256 * 4096; const bf16* W2T = (const bf16*)(c.ws + WS_CW2) + (size_t)mt * 128 * 256; const float* B1 = (const float*)(c.ws + WS_CB1) + mt * 256;
        const bf16* xrow = P + (size_t)(16 * (n0 + qi)) * C_INP + (tensor ? 2560 : 2048) + g * 128 + 8 * g4;
        const bf16* wrow0 = W1T + (size_t)(32 * c.wave + qi) * 4096 + 8 * g4; const bf16* wrow1 = wrow0 + 16 * 4096;
        f32x4 a0 = (f32x4){0.f, 0.f, 0.f, 0.f}, a1 = (f32x4){0.f, 0.f, 0.f, 0.f};
#pragma unroll 8
        for (int ks = 0; ks < 128; ++ks) { const bf16x8 xf = *(const bf16x8*)(xrow + (size_t)(ks >> 2) * C_INP + 32 * (ks & 3));
            a0 = mfma16(*(const bf16x8*)(wrow0 + 32 * ks), xf, a0); a1 = mfma16(*(const bf16x8*)(wrow1 + 32 * ks), xf, a1); }
#pragma unroll
        for (int cg = 0; cg < 2; ++cg) { const int j0 = 32 * c.wave + 16 * cg + 4 * g4; const f32x4 b = *(const f32x4*)(B1 + j0); const f32x4 a = (cg ? a1 : a0) + b;
            v2u w; w.x = cvtpk(gelu_tanh(a[0]), gelu_tanh(a[1])); w.y = cvtpk(gelu_tanh(a[2]), gelu_tanh(a[3])); *(LAS v2u*)(Hs + qi * 528 + j0 * 2) = w; }
        __syncthreads();
        f32x4 o = (f32x4){0.f, 0.f, 0.f, 0.f};
        const bf16* w2row = W2T + (size_t)(16 * c.wave + qi) * 256 + 8 * g4;
#pragma unroll
        for (int k2 = 0; k2 < 8; ++k2) o = mfma16(*(const bf16x8*)(w2row + 32 * k2), *(const LAS bf16x8*)(Hs + qi * 528 + (32 * k2 + 8 * g4) * 2), o);
        const int n = n0 + qi; if (n == 511) o = (f32x4){0.f, 0.f, 0.f, 0.f};
        v2u w; w.x = cvtpk(o[0], o[1]); w.y = cvtpk(o[2], o[3]);
        *(v2u*)((bf16*)(c.ws + (tensor ? WS_CV : WS_CK)) + (size_t)(g * 512 + n) * 128 + 16 * c.wave + 4 * g4) = w;
        __syncthreads();
    }
}

#define NSA_UNIT_SETUP() \
    const int g = u >> 7, tb = u & 127, t0 = 64 * tb; int qt[2]; const bf16* qrow[2]; bf16x8 qf[2][4]; \
    _Pragma("unroll") for (int qg = 0; qg < 2; ++qg) { qt[qg] = t0 + 8 * c.wave + 4 * qg + (G.qi >> 2); qrow[qg] = P + (size_t)qt[qg] * C_INP; \
        _Pragma("unroll") for (int ks = 0; ks < 4; ++ks) qf[qg][ks] = *(const bf16x8*)(qrow[qg] + (4 * g + (G.qi & 3)) * 128 + 32 * ks + 8 * G.g4); } \
    float m[2] = {-1e30f, -1e30f}, l[2] = {0.f, 0.f}; f32x4 o[2][8]; \
    _Pragma("unroll") for (int qg = 0; qg < 2; ++qg) _Pragma("unroll") for (int db = 0; db < 8; ++db) o[qg][db] = (f32x4){0.f, 0.f, 0.f, 0.f};

__device__ __forceinline__ void phase_nsa_window(const Ctx& c) {
    const bf16* P = (const bf16*)(c.ws + WS_P); bf16* OACC = (bf16*)(c.ws + WS_OACC);
    const LaneGeo G = lane_geo(c.lane);
    for (int u = c.bid; u < 512; u += c.G) {
        NSA_UNIT_SETUP();
        const bf16* kb = P + 4096 + g * 128; const bf16* vb = P + 4608 + g * 128;
        const int Tf = tb >= 8 ? 0 : 8 - tb;
        { const int k0 = t0 - 512 + 64 * Tf; auto rp = [=](int row, const bf16*& kp, const bf16*& vp) -> void { kp = kb + (size_t)(k0 + row) * C_INP; vp = vb + (size_t)(k0 + row) * C_INP; };
          tile_dma(c.lds + ATT_K0, c.lds + ATT_V0, rp, c.wave, c.lane); }
        TILE_SYNC();
        for (int T = Tf; T <= 8; ++T) {
            const int cur = (T - Tf) & 1, k0 = t0 - 512 + 64 * T;
            if (T < 8) { const int k1 = k0 + 64; auto rp = [=](int row, const bf16*& kp, const bf16*& vp) -> void { kp = kb + (size_t)(k1 + row) * C_INP; vp = vb + (size_t)(k1 + row) * C_INP; }; tile_dma(c.lds + (cur ? ATT_K0 : ATT_K1), c.lds + (cur ? ATT_V0 : ATT_V1), rp, c.wave, c.lane); }
            const int dq0 = qt[0] - k0, dq1 = qt[1] - k0;
            auto mask = [=](int qg, int key) -> bool { return (unsigned)((qg ? dq1 : dq0) - key) < 512u; };
            attn_tile(c.lds + (cur ? ATT_K1 : ATT_K0), c.lds + (cur ? ATT_V1 : ATT_V0), G, qf, m, l, o, T == 0 || T == 8, mask);
            TILE_SYNC();
        }
#pragma unroll
        for (int qg = 0; qg < 2; ++qg) { float lt = l[qg]; lt += __shfl_xor(lt, 16); lt += __shfl_xor(lt, 32);
            const int h = 4 * g + (G.qi & 3); const float sc = sigmoid_f(bf2f(qrow[qg][5120 + 3 * h + 2])) / lt;
            bf16* dst = OACC + (size_t)qt[qg] * C_OUT + h * 128 + 4 * G.g4;
#pragma unroll
            for (int db = 0; db < 8; ++db) { v2u w; w.x = cvtpk(o[qg][db][0] * sc, o[qg][db][1] * sc); w.y = cvtpk(o[qg][db][2] * sc, o[qg][db][3] * sc); *(v2u*)(dst + 16 * db) = w; } }
    }
}
constexpr int IMP_LD = 132;
__device__ __forceinline__ void phase_nsa_cmp(const Ctx& c) {
    const bf16* P = (const bf16*)(c.ws + WS_P); bf16* OACC = (bf16*)(c.ws + WS_OACC); unsigned* BM = (unsigned*)(c.ws + WS_BM);
    const bf16* CK = (const bf16*)(c.ws + WS_CK); const bf16* CV = (const bf16*)(c.ws + WS_CV);
    const LaneGeo G = lane_geo(c.lane);
    LAS float* imp = (LAS float*)(c.lds + ATT_X);
    for (int u = c.bid; u < 512; u += c.G) {
        NSA_UNIT_SETUP();
        const bf16* kb = CK + (size_t)g * 512 * 128; const bf16* vb = CV + (size_t)g * 512 * 128;
        const int ncmax = ((t0 + 32) >> 4) + 1, NT = (ncmax + 63) >> 6;
        int nmax[2]; float gate[2];
#pragma unroll
        for (int qg = 0; qg < 2; ++qg) { nmax[qg] = qt[qg] >= 31 ? ((qt[qg] - 31) >> 4) : -1; gate[qg] = sigmoid_f(bf2f(qrow[qg][5120 + 3 * (4 * g + (G.qi & 3)) + 0])); }
        for (int i = c.tid; i < 64 * IMP_LD; i += NTHREADS) imp[i] = 0.f;
        { auto rp = [=](int row, const bf16*& kp, const bf16*& vp) -> void { kp = kb + (size_t)row * 128; vp = vb + (size_t)row * 128; };
          tile_dma(c.lds + ATT_K0, c.lds + ATT_V0, rp, c.wave, c.lane); }
        TILE_SYNC();
        for (int T = 0; T < NT; ++T) {
            const int cur = T & 1, n0 = 64 * T;
            if (T + 1 < NT) { const int n1 = n0 + 64; auto rp = [=](int row, const bf16*& kp, const bf16*& vp) -> void { kp = kb + (size_t)(n1 + row) * 128; vp = vb + (size_t)(n1 + row) * 128; }; tile_dma(c.lds + (cur ? ATT_K0 : ATT_K1), c.lds + (cur ? ATT_V0 : ATT_V1), rp, c.wave, c.lane); }
            const int d0 = nmax[0] - n0, d1 = nmax[1] - n0;
            auto mask = [=](int qg, int key) -> bool { return key <= (qg ? d1 : d0); };
            attn_tile(c.lds + (cur ? ATT_K1 : ATT_K0), c.lds + (cur ? ATT_V1 : ATT_V0), G, qf, m, l, o, true, mask);
            TILE_SYNC();
        }
        float linv[2];
#pragma unroll
        for (int qg = 0; qg < 2; ++qg) { float lt = l[qg]; lt += __shfl_xor(lt, 16); lt += __shfl_xor(lt, 32); linv[qg] = lt > 0.f ? 1.0f / lt : 0.f; }
#pragma unroll
        for (int qg = 0; qg < 2; ++qg) { const int h = 4 * g + (G.qi & 3); const float sc = gate[qg] * linv[qg];
            bf16* dst = OACC + (size_t)qt[qg] * C_OUT + h * 128 + 4 * G.g4;
#pragma unroll
            for (int db = 0; db < 8; ++db) { const v2u old = *(const v2u*)(dst + 16 * db);
                v2u w; w.x = cvtpk(bflo(old.x) + o[qg][db][0] * sc, bfhi(old.x) + o[qg][db][1] * sc); w.y = cvtpk(bflo(old.y) + o[qg][db][2] * sc, bfhi(old.y) + o[qg][db][3] * sc); *(v2u*)(dst + 16 * db) = w; } }
        { auto rp = [=](int row, const bf16*& kp, const bf16*& vp) -> void { kp = kb + (size_t)row * 128; vp = vb + (size_t)row * 128; };
          tile_dma(c.lds + ATT_K0, c.lds + ATT_V0, rp, c.wave, c.lane); }
        TILE_SYNC();
        for (int T = 0; T < NT; ++T) {
            const int cur = T & 1, n0 = 64 * T;
            if (T + 1 < NT) { const int n1 = n0 + 64; auto rp = [=](int row, const bf16*& kp, const bf16*& vp) -> void { kp = kb + (size_t)(n1 + row) * 128; vp = vb + (size_t)(n1 + row) * 128; }; tile_dma(c.lds + (cur ? ATT_K0 : ATT_K1), c.lds + (cur ? ATT_V0 : ATT_V1), rp, c.wave, c.lane); }
            const int d0 = nmax[0] - n0, d1 = nmax[1] - n0;
            auto mask = [=](int qg, int key) -> bool { return key <= (qg ? d1 : d0); };
            f32x4 s[2][4];
            attn_scores(s, c.lds + (cur ? ATT_K1 : ATT_K0), G, qf, true, mask);
#pragma unroll
            for (int qg = 0; qg < 2; ++qg)
#pragma unroll
                for (int kg = 0; kg < 4; ++kg) {
                    const float p0 = __builtin_amdgcn_exp2f(s[qg][kg][0] - m[qg]), p1 = __builtin_amdgcn_exp2f(s[qg][kg][1] - m[qg]), p2 = __builtin_amdgcn_exp2f(s[qg][kg][2] - m[qg]), p3 = __builtin_amdgcn_exp2f(s[qg][kg][3] - m[qg]);
                    float sa = ((p0 + p1) + (p2 + p3)) * linv[qg], sb = p3 * linv[qg];
                    sa += __shfl_xor(sa, 1); sa += __shfl_xor(sa, 2); sb += __shfl_xor(sb, 1); sb += __shfl_xor(sb, 2);
                    if ((G.qi & 3) == 0) { const int tl = 8 * c.wave + 4 * qg + (G.qi >> 2), bA = 16 * T + 4 * kg + G.g4;
                        __hip_atomic_fetch_add(imp + tl * IMP_LD + bA, sa, __ATOMIC_RELAXED, __HIP_MEMORY_SCOPE_WORKGROUP);
                        if (bA + 1 < 128) __hip_atomic_fetch_add(imp + tl * IMP_LD + bA + 1, sb, __ATOMIC_RELAXED, __HIP_MEMORY_SCOPE_WORKGROUP); }
                }
            TILE_SYNC();
        }
        for (int ti = 0; ti < 8; ++ti) {
            const int tl = 8 * c.wave + ti, t = t0 + tl, curb = t >> 6; float sc[2];
#pragma unroll
            for (int i = 0; i < 2; ++i) { const int mb = c.lane + 64 * i; const bool forced = (mb == 0) || (mb == curb) || (mb == curb - 1);
                sc[i] = (mb <= curb) ? imp[tl * IMP_LD + mb] + (forced ? 1e4f : 0.f) : -__builtin_inff(); }
            int rk0 = 0, rk1 = 0;
#pragma unroll 4
            for (int jj = 0; jj < 64; ++jj) { const float a = rdlane(sc[0], jj), b = rdlane(sc[1], jj);
                rk0 += (a > sc[0] || (a == sc[0] && jj < c.lane)) ? 1 : 0; rk0 += (b > sc[0]) ? 1 : 0;
                rk1 += (a >= sc[1]) ? 1 : 0; rk1 += (b > sc[1] || (b == sc[1] && jj < c.lane)) ? 1 : 0; }
            const bool sel0 = (sc[0] > -__builtin_inff()) && rk0 < 16, sel1 = (sc[1] > -__builtin_inff()) && rk1 < 16;
            const unsigned long long mk0 = __ballot(sel0), mk1 = __ballot(sel1);
            if (c.lane == 0) *(v4u*)(BM + ((size_t)g * S_ + t) * 4) = (v4u){(unsigned)mk0, (unsigned)(mk0 >> 32), (unsigned)mk1, (unsigned)(mk1 >> 32)};
        }
        __syncthreads();
    }
}
__device__ __forceinline__ void phase_nsa_sel(const Ctx& c) {
    const bf16* P = (const bf16*)(c.ws + WS_P); const bf16* OACC = (const bf16*)(c.ws + WS_OACC); bf16* CAT = (bf16*)(c.ws + WS_CAT); const unsigned* BM = (const unsigned*)(c.ws + WS_BM);
    const LaneGeo G = lane_geo(c.lane);
    LAS unsigned* bms = (LAS unsigned*)(c.lds + ATT_X);
    for (int u = c.bid; u < 512; u += c.G) {
        NSA_UNIT_SETUP();
        const bf16* kb = P + 3072 + g * 128; const bf16* vb = P + 3584 + g * 128;
        if (c.tid < 256) bms[c.tid] = BM[((size_t)g * S_ + t0) * 4 + c.tid];
        { auto rp = [=](int row, const bf16*& kp, const bf16*& vp) -> void { kp = kb + (size_t)row * C_INP; vp = vb + (size_t)row * C_INP; };
          tile_dma(c.lds + ATT_K0, c.lds + ATT_V0, rp, c.wave, c.lane); }
        TILE_SYNC();
        const int tl0 = 8 * c.wave + (G.qi >> 2), tl1 = tl0 + 4;
        for (int T = 0; T <= tb; ++T) {
            const int cur = T & 1, k0 = 64 * T;
            if (T < tb) { const int k1 = k0 + 64; auto rp = [=](int row, const bf16*& kp, const bf16*& vp) -> void { kp = kb + (size_t)(k1 + row) * C_INP; vp = vb + (size_t)(k1 + row) * C_INP; }; tile_dma(c.lds + (cur ? ATT_K0 : ATT_K1), c.lds + (cur ? ATT_V0 : ATT_V1), rp, c.wave, c.lane); }
            const bool b0 = (bms[tl0 * 4 + (T >> 5)] >> (T & 31)) & 1u, b1 = (bms[tl1 * 4 + (T >> 5)] >> (T & 31)) & 1u;
            if (__ballot(b0 || b1) != 0ull) {
                const int dq0 = qt[0] - k0, dq1 = qt[1] - k0;
                auto mask = [=](int qg, int key) -> bool { return (qg ? b1 : b0) && key <= (qg ? dq1 : dq0); };
                attn_tile(c.lds + (cur ? ATT_K1 : ATT_K0), c.lds + (cur ? ATT_V1 : ATT_V0), G, qf, m, l, o, true, mask);
            }
            TILE_SYNC();
        }
#pragma unroll
        for (int qg = 0; qg < 2; ++qg) { float lt = l[qg]; lt += __shfl_xor(lt, 16); lt += __shfl_xor(lt, 32);
            const int h = 4 * g + (G.qi & 3); const float sc = sigmoid_f(bf2f(qrow[qg][5120 + 3 * h + 1])) / lt;
            const bf16* src = OACC + (size_t)qt[qg] * C_OUT + h * 128 + 4 * G.g4; bf16* dst = CAT + (size_t)qt[qg] * C_OUT + h * 128 + 4 * G.g4;
#pragma unroll
            for (int db = 0; db < 8; ++db) { const v2u old = *(const v2u*)(src + 16 * db);
                v2u w; w.x = cvtpk(bflo(old.x) + o[qg][db][0] * sc, bfhi(old.x) + o[qg][db][1] * sc); w.y = cvtpk(bflo(old.y) + o[qg][db][2] * sc, bfhi(old.y) + o[qg][db][3] * sc); *(v2u*)(dst + 16 * db) = w; } }
    }
}

template <class RP1> __device__ __forceinline__ void img_dma(LAS unsigned char* img, int nrows, const RP1& rp, int wave, int lane) {
    for (int p = wave; p < nrows / 4; p += 8) { const int row = 4 * p + (lane >> 4), ch = (lane & 15) ^ (((row & 3) << 2) | ((row >> 2) & 3));
        __builtin_amdgcn_global_load_lds((const unsigned*)(rp(row) + 8 * ch), (LAS unsigned*)(img + 1024 * p), 16, 0, 0); }
}
__device__ __forceinline__ int tr_off(int rb4, int cblk, int qi) { const int q = qi >> 2, p = qi & 3; return 256 * (rb4 + q) + 16 * ((2 * cblk + (p >> 1)) ^ ((q << 2) | ((rb4 >> 2) & 3))) + 8 * (p & 1); }
__device__ __forceinline__ bf16x8 tr_frag(const LAS unsigned char* img, int rbA, int rbB, int cblk, int qi) {
    const s16x4 lo = vtr(img + tr_off(rbA, cblk, qi)), hi = vtr(img + tr_off(rbB, cblk, qi)); return __builtin_shufflevector(lo, hi, 0, 1, 2, 3, 4, 5, 6, 7); }

constexpr size_t DST_O_FLOATS = (size_t)S_ * 1024;
__device__ __forceinline__ void phase_dil(const Ctx& c, int pi) {
    const bf16* P = (const bf16*)(c.ws + WS_P); bf16* CAT = (bf16*)(c.ws + WS_CAT); float* DO = (float*)(c.ws + WS_DST); float* DML = DO + DST_O_FLOATS;
    const LaneGeo G = lane_geo(c.lane);
    const int dil = pi == 0 ? 1 : (pi == 1 ? 4 : 16), nper = 32 / dil;
    for (int u = c.bid; u < 256; u += c.G) {
        const int h = u & 7, other = u >> 3, r = other / nper, uu = other % nper;
        int qidx[2], qt[2]; bf16x8 qf[2][4];
#pragma unroll
        for (int qg = 0; qg < 2; ++qg) { qidx[qg] = 256 * uu + 32 * c.wave + 16 * qg + G.qi; qt[qg] = qidx[qg] * dil + r;
#pragma unroll
            for (int ks = 0; ks < 4; ++ks) qf[qg][ks] = *(const bf16x8*)(P + (size_t)qt[qg] * AB_IN + 6144 + h * 128 + 32 * ks + 8 * G.g4); }
        float m[2], l[2]; f32x4 o[2][8];
#pragma unroll
        for (int qg = 0; qg < 2; ++qg) {
            if (pi == 0) { m[qg] = -1e30f; l[qg] = 0.f;
#pragma unroll
                for (int db = 0; db < 8; ++db) o[qg][db] = (f32x4){0.f, 0.f, 0.f, 0.f}; }
            else { const size_t sb = (size_t)qt[qg] * 8 + h; m[qg] = DML[sb * 2]; l[qg] = G.g4 == 0 ? DML[sb * 2 + 1] : 0.f;
#pragma unroll
                for (int db = 0; db < 8; ++db) o[qg][db] = *(const f32x4*)(DO + sb * 128 + 16 * db + 4 * G.g4); }
        }
        const bf16* kb = P + 7168 + h * 128; const bf16* vb = P + 8192 + h * 128;
        const int Tf = uu == 0 ? 2 : 0;
        { const int k0 = 256 * uu - 128 + 64 * Tf; auto rp = [=](int row, const bf16*& kp, const bf16*& vp) -> void { const size_t tok = (size_t)((k0 + row) * dil + r); kp = kb + tok * AB_IN; vp = vb + tok * AB_IN; };
          tile_dma(c.lds + ATT_K0, c.lds + ATT_V0, rp, c.wave, c.lane); }
        TILE_SYNC();
        for (int T = Tf; T < 6; ++T) {
            const int cur = (T - Tf) & 1, k0 = 256 * uu - 128 + 64 * T;
            if (T < 5) { const int k1 = k0 + 64; auto rp = [=](int row, const bf16*& kp, const bf16*& vp) -> void { const size_t tok = (size_t)((k1 + row) * dil + r); kp = kb + tok * AB_IN; vp = vb + tok * AB_IN; };
                tile_dma(c.lds + (cur ? ATT_K0 : ATT_K1), c.lds + (cur ? ATT_V0 : ATT_V1), rp, c.wave, c.lane); }
            if (64 * T + 63 >= 32 * c.wave && 64 * T <= 32 * c.wave + 159) {
                const int dq0 = qidx[0] - k0, dq1 = qidx[1] - k0;
                auto mask = [=](int qg, int key) -> bool { return (unsigned)((qg ? dq1 : dq0) - key) < 129u; };
                attn_tile(c.lds + (cur ? ATT_K1 : ATT_K0), c.lds + (cur ? ATT_V1 : ATT_V0), G, qf, m, l, o, true, mask);
            }
            TILE_SYNC();
        }
#pragma unroll
        for (int qg = 0; qg < 2; ++qg) { float lt = l[qg]; lt += __shfl_xor(lt, 16); lt += __shfl_xor(lt, 32);
            if (pi < 2) { const size_t sb = (size_t)qt[qg] * 8 + h; if (G.g4 == 0) { DML[sb * 2] = m[qg]; DML[sb * 2 + 1] = lt; }
#pragma unroll
                for (int db = 0; db < 8; ++db) *(f32x4*)(DO + sb * 128 + 16 * db + 4 * G.g4) = o[qg][db]; }
            else { const float sc = 1.0f / lt; bf16* dst = CAT + (size_t)qt[qg] * AB_OUT + 2048 + h * 128 + 4 * G.g4;
#pragma unroll
                for (int db = 0; db < 8; ++db) { v2u w; w.x = cvtpk(o[qg][db][0] * sc, o[qg][db][1] * sc); w.y = cvtpk(o[qg][db][2] * sc, o[qg][db][3] * sc); *(v2u*)(dst + 16 * db) = w; } }
        }
    }
}

constexpr int RK_IMG = 0, RV_IMG0 = 32768, RV_IMG1 = 65536;
__device__ __forceinline__ void phase_ret_kv(const Ctx& c) {
    const bf16* P = (const bf16*)(c.ws + WS_P); float* KV = (float*)(c.ws + WS_KV);
    const int qi = c.lane & 15, g4 = c.lane >> 4;
    for (int u = c.bid; u < 512; u += c.G) {
        const int h = u >> 6, n = u & 63; const float lg = ret_log_gamma(h);
        { const bf16* vsrc = P + (size_t)(128 * n) * AB_IN + 2048 + h * 256;
          auto rp0 = [=](int row) -> const bf16* { return vsrc + (size_t)row * AB_IN; }; auto rp1 = [=](int row) -> const bf16* { return vsrc + (size_t)row * AB_IN + 128; };
          img_dma(c.lds + RV_IMG0, 128, rp0, c.wave, c.lane); img_dma(c.lds + RV_IMG1, 128, rp1, c.wave, c.lane); }
#pragma unroll
        for (int i = 0; i < 4; ++i) { const int ci = c.tid + 512 * i, row = ci >> 4, ch = ci & 15;
            const v4u v = *(const v4u*)(P + (size_t)(128 * n + row) * AB_IN + 1024 + h * 128 + 8 * ch); const float zs = RET_SCALE * __expf(lg * (float)(127 - row));
            v4u w; w.x = cvtpk(bflo(v.x) * zs, bfhi(v.x) * zs); w.y = cvtpk(bflo(v.y) * zs, bfhi(v.y) * zs); w.z = cvtpk(bflo(v.z) * zs, bfhi(v.z) * zs); w.w = cvtpk(bflo(v.w) * zs, bfhi(v.w) * zs);
            *(LAS v4u*)(c.lds + RK_IMG + off_b(row, ch)) = w; }
        TILE_SYNC();
        f32x4 acc[16];
#pragma unroll
        for (int i = 0; i < 16; ++i) acc[i] = (f32x4){0.f, 0.f, 0.f, 0.f};
#pragma unroll
        for (int ks = 0; ks < 4; ++ks) {
            const bf16x8 kf = tr_frag(c.lds + RK_IMG, 32 * ks + 8 * g4, 32 * ks + 8 * g4 + 4, c.wave, qi);
#pragma unroll
            for (int dvb = 0; dvb < 16; ++dvb) { const bf16x8 vf = tr_frag(c.lds + (dvb < 8 ? RV_IMG0 : RV_IMG1), 32 * ks + 8 * g4, 32 * ks + 8 * g4 + 4, dvb & 7, qi);
                acc[dvb] = mfma16(vf, kf, acc[dvb]); }
            asm volatile("" ::: "memory");
        }
        float* dst = KV + ((size_t)(h * 64 + n) * 128 + 16 * c.wave + qi) * 256 + 4 * g4;
#pragma unroll
        for (int dvb = 0; dvb < 16; ++dvb) *(f32x4*)(dst + 16 * dvb) = acc[dvb];
        __syncthreads();
    }
}
__device__ __forceinline__ void phase_ret_scan(const Ctx& c) {
    const float* KV = (const float*)(c.ws + WS_KV); bf16* PV = (bf16*)(c.ws + WS_PREV);
    for (int it = c.bid * NTHREADS + c.tid; it < 8 * 128 * 64; it += c.G * NTHREADS) {
        const int h = it >> 13, rem = it & 8191; const float cd = __expf(ret_log_gamma(h) * 128.0f);
        const size_t off = (size_t)h * 64 * 32768 + (size_t)rem * 4;
        f32x4 st = (f32x4){0.f, 0.f, 0.f, 0.f};
#pragma unroll 4
        for (int n = 0; n < 64; ++n) { const f32x4 kv = *(const f32x4*)(KV + off + (size_t)n * 32768);
            v2u w; w.x = cvtpk(st[0], st[1]); w.y = cvtpk(st[2], st[3]); *(v2u*)(PV + off + (size_t)n * 32768) = w; st = st * cd + kv; }
    }
}
constexpr int RO_PRV0 = 0, RO_PRV1 = 32768, RO_K = 65536, RO_V0 = 0, RO_V1 = 32768;
__device__ __forceinline__ void phase_ret_out(const Ctx& c) {
    const bf16* P = (const bf16*)(c.ws + WS_P); const bf16* PV = (const bf16*)(c.ws + WS_PREV); bf16* CAT = (bf16*)(c.ws + WS_CAT);
    const int qi = c.lane & 15, g4 = c.lane >> 4;
    int koff[4];
    { const int kx = ((qi & 3) << 2) | (qi >> 2);
#pragma unroll
      for (int ks = 0; ks < 4; ++ks) koff[ks] = 256 * qi + 16 * ((4 * ks + g4) ^ kx); }
    for (int u = c.bid; u < 512; u += c.G) {
        const int h = u >> 6, n = u & 63, q = 16 * c.wave + qi, tok = 128 * n + q; const float lg = ret_log_gamma(h), lg2 = lg * 1.4426950408889634f;
        bf16x8 qf[4];
#pragma unroll
        for (int ks = 0; ks < 4; ++ks) qf[ks] = *(const bf16x8*)(P + (size_t)tok * AB_IN + h * 128 + 32 * ks + 8 * g4);
        { const bf16* ps = PV + (size_t)(h * 64 + n) * 32768; const bf16* ksrc = P + (size_t)(128 * n) * AB_IN + 1024 + h * 128;
          auto rp0 = [=](int row) -> const bf16* { return ps + (size_t)row * 256; }; auto rp1 = [=](int row) -> const bf16* { return ps + (size_t)row * 256 + 128; };
          auto rpk = [=](int row) -> const bf16* { return ksrc + (size_t)row * AB_IN; };
          img_dma(c.lds + RO_PRV0, 128, rp0, c.wave, c.lane); img_dma(c.lds + RO_PRV1, 128, rp1, c.wave, c.lane); img_dma(c.lds + RO_K, 128, rpk, c.wave, c.lane); }
        TILE_SYNC();
        f32x4 acc[16];
#pragma unroll
        for (int i = 0; i < 16; ++i) acc[i] = (f32x4){0.f, 0.f, 0.f, 0.f};
#pragma unroll
        for (int ks = 0; ks < 4; ++ks) {
#pragma unroll
            for (int dvb = 0; dvb < 16; ++dvb) { const bf16x8 pf = tr_frag(c.lds + (dvb < 8 ? RO_PRV0 : RO_PRV1), 32 * ks + 8 * g4, 32 * ks + 8 * g4 + 4, dvb & 7, qi);
                acc[dvb] = mfma16(pf, qf[ks], acc[dvb]); }
            asm volatile("" ::: "memory");
        }
        { const float xi = __builtin_amdgcn_exp2f(lg2 * (float)(q + 1));
#pragma unroll
          for (int i = 0; i < 16; ++i) acc[i] *= xi; }
        __syncthreads();
        { const bf16* vsrc = P + (size_t)(128 * n) * AB_IN + 2048 + h * 256;
          auto rp0 = [=](int row) -> const bf16* { return vsrc + (size_t)row * AB_IN; }; auto rp1 = [=](int row) -> const bf16* { return vsrc + (size_t)row * AB_IN + 128; };
          img_dma(c.lds + RO_V0, 128, rp0, c.wave, c.lane); img_dma(c.lds + RO_V1, 128, rp1, c.wave, c.lane); }
        bf16x8 pb[4];
#pragma unroll
        for (int k2 = 0; k2 < 4; ++k2) {
            f32x4 s0 = (f32x4){0.f, 0.f, 0.f, 0.f}, s1 = (f32x4){0.f, 0.f, 0.f, 0.f};
            if (2 * k2 <= c.wave) {
#pragma unroll
                for (int ks = 0; ks < 4; ++ks) { s0 = mfma16(*(const LAS bf16x8*)(c.lds + RO_K + 4096 * (2 * k2) + koff[ks]), qf[ks], s0); s1 = mfma16(*(const LAS bf16x8*)(c.lds + RO_K + 4096 * (2 * k2 + 1) + koff[ks]), qf[ks], s1); }
#pragma unroll
                for (int r = 0; r < 4; ++r) { const int ka = 32 * k2 + 4 * g4 + r, kb2 = ka + 16;
                    s0[r] = ka <= q ? s0[r] * RET_SCALE * __builtin_amdgcn_exp2f(lg2 * (float)(q - ka)) : 0.f; s1[r] = kb2 <= q ? s1[r] * RET_SCALE * __builtin_amdgcn_exp2f(lg2 * (float)(q - kb2)) : 0.f; }
            }
            v4u w; w.x = cvtpk(s0[0], s0[1]); w.y = cvtpk(s0[2], s0[3]); w.z = cvtpk(s1[0], s1[1]); w.w = cvtpk(s1[2], s1[3]); pb[k2] = __builtin_bit_cast(bf16x8, w);
        }
        TILE_SYNC();
#pragma unroll
        for (int k2 = 0; k2 < 4; ++k2) {
            if (2 * k2 <= c.wave) {
#pragma unroll
                for (int dvb = 0; dvb < 16; ++dvb) { const bf16x8 vf = tr_frag(c.lds + (dvb < 8 ? RO_V0 : RO_V1), 32 * k2 + 4 * g4, 32 * k2 + 16 + 4 * g4, dvb & 7, qi);
                    acc[dvb] = mfma16(vf, pb[k2], acc[dvb]); }
            }
            asm volatile("" ::: "memory");
        }
        float sm = 0.f;
#pragma unroll
        for (int i = 0; i < 16; ++i) sm += (acc[i][0] + acc[i][1]) + (acc[i][2] + acc[i][3]);
        sm += __shfl_xor(sm, 16); sm += __shfl_xor(sm, 32);
        const float mean = sm * (1.0f / 256.0f); float vs = 0.f;
#pragma unroll
        for (int i = 0; i < 16; ++i) { acc[i] = acc[i] - mean; vs += (acc[i][0] * acc[i][0] + acc[i][1] * acc[i][1]) + (acc[i][2] * acc[i][2] + acc[i][3] * acc[i][3]); }
        vs += __shfl_xor(vs, 16); vs += __shfl_xor(vs, 32);
        const float rs = 1.0f / sqrtf(vs * (1.0f / 256.0f) + NORM_EPS);
        const bf16* gsrc = P + (size_t)tok * AB_IN + 4096 + h * 256 + 4 * g4; bf16* dst = CAT + (size_t)tok * AB_OUT + h * 256 + 4 * g4;
#pragma unroll
        for (int dvb = 0; dvb < 16; ++dvb) { const v2u gv = *(const v2u*)(gsrc + 16 * dvb); const float g0 = bflo(gv.x), g1 = bfhi(gv.x), g2 = bflo(gv.y), g3 = bfhi(gv.y);
            v2u w; w.x = cvtpk(g0 * sigmoid_f(g0) * acc[dvb][0] * rs, g1 * sigmoid_f(g1) * acc[dvb][1] * rs); w.y = cvtpk(g2 * sigmoid_f(g2) * acc[dvb][2] * rs, g3 * sigmoid_f(g3) * acc[dvb][3] * rs);
            *(v2u*)(dst + 16 * dvb) = w; }
        __syncthreads();
    }
}

struct Args { const float* in[16]; float* out; unsigned char* ws; int ph_lo, ph_hi; };
__device__ __forceinline__ Ctx make_ctx(const Args& args, LAS unsigned char* lds, int wave_s) {
    Ctx c; c.lds = lds;
    const float* const* in = args.in;
    c.x = in[0]; c.pos = (const int*)in[1]; c.norm_g = in[2]; c.w1 = in[3]; c.w3 = in[4]; c.w2 = in[5]; c.ab_in = in[6]; c.ab_out = in[7];
    c.c_in = in[8]; c.c_out = in[9]; c.ck_w1 = in[10]; c.ck_w2 = in[11]; c.cv_w1 = in[12]; c.cv_w2 = in[13]; c.pe_k = in[14]; c.pe_v = in[15];
    float* out = args.out; unsigned char* ws = args.ws; asm volatile("" : "+s"(out), "+s"(ws));
    c.out = out; c.ws = ws;
    int lane, bid = blockIdx.x, G = gridDim.x;
    asm volatile("v_mbcnt_lo_u32_b32 %0, -1, 0\n\tv_mbcnt_hi_u32_b32 %0, -1, %0" : "=v"(lane));
    asm volatile("" : "+s"(wave_s), "+s"(bid), "+s"(G));
    c.lane = lane; c.wave = wave_s; c.tid = wave_s * 64 + lane; c.bid = bid; c.G = G; c.gw = c.bid * NWAVES + c.wave; c.NGW = c.G * NWAVES;
    return c;
}
__global__ void __launch_bounds__(NTHREADS, 2) mk_fwd(Args args) {
    extern __shared__ __attribute__((aligned(16))) unsigned char lds_raw[];
    LAS unsigned char* const lds = (LAS unsigned char*)lds_raw;
    for (int u = threadIdx.x; u < (LDS_BYTES - RING_BYTES) / 4; u += NTHREADS) ((LAS unsigned*)(lds + RING_BYTES))[u] = 0u;
    __syncthreads();
    const int lo = args.ph_lo, hi = args.ph_hi; const int wave_s = __builtin_amdgcn_readfirstlane(threadIdx.x >> 6);
#if MK_FUSED
    XcdBarrier bar = xcd_barrier_post((unsigned*)(args.ws + WS_CTL) + CW_BAR, (volatile LAS unsigned*)(lds + MISC_OFF) + 8);
#define GRID_BAR() xcd_barrier(bar)
#else
#define GRID_BAR() do { } while (0)
#endif
#define IN(k) (lo <= (k) && (k) < hi)
#define SEAM(k) do { if (IN(k) && IN((k) + 1)) GRID_BAR(); } while (0)
#define CTX() const Ctx c = make_ctx(args, lds, wave_s)
#define WSP(T, off) ((T*)(c.ws + (off)))

    if (IN(0)) { CTX(); phase_prologue(c); }
    SEAM(0);
#pragma unroll 1
    for (int L = 0; L < DEPTH; ++L) {
        const int base = 1 + 13 * L, jx = L >> 1; const bool odd = (L & 1) != 0;
        if (IN(base + 0)) { CTX(); pg8::Gemm g{WSP(bf16, WS_H), (const bf16*)(c.ws + WS_W13 + (size_t)(2 * L) * SZ_W13), S_, NUP, D_}; pg8::StaticOrder So; So.init(S_, NUP, c.G, c.bid);
            pg8::EpiSwiglu E{WSP(bf16, WS_P), DFF}; pg8::gemm_phase<pg8::EpiSwiglu, pg8::StaticOrder, true, true>(c.lds, g, So, E, c.tid); }
        SEAM(base + 0);
        if (IN(base + 1)) { CTX(); pg8::Gemm g{WSP(bf16, WS_P), (const bf16*)(c.ws + WS_W2 + (size_t)(2 * L) * SZ_W2), S_, D_, DFF}; pg8::StaticOrder So; So.init(S_, D_, c.G, c.bid);
            pg8::EpiStore E{WSP(bf16, WS_Y), D_}; pg8::gemm_phase<pg8::EpiStore, pg8::StaticOrder, true, true>(c.lds, g, So, E, c.tid); }
        SEAM(base + 1);
        if (IN(base + 2)) { CTX(); const float* ng = c.norm_g + (size_t)L * 6 * D_; phase_rowpass(c, ng + 1 * D_, 0.5f, ng + 2 * D_); }
        SEAM(base + 2);
        if (!odd) {
            if (IN(base + 3)) { CTX(); pg8::Gemm g{WSP(bf16, WS_H), (const bf16*)(c.ws + WS_ABIN + (size_t)jx * SZ_ABIN), S_, AB_IN, D_}; pg8::StaticOrder So; So.init(S_, AB_IN, c.G, c.bid);
                pg8::EpiStore E{WSP(bf16, WS_P), AB_IN}; pg8::gemm_phase<pg8::EpiStore, pg8::StaticOrder, true, true>(c.lds, g, So, E, c.tid); }
            SEAM(base + 3);
            if (IN(base + 4)) { CTX(); phase_rope_even(c); }
            SEAM(base + 4);
            if (IN(base + 5)) { { CTX(); phase_ret_kv(c); } { CTX(); phase_dil(c, 0); } }
            SEAM(base + 5);
            if (IN(base + 6)) { { CTX(); phase_ret_scan(c); } { CTX(); phase_dil(c, 1); } }
            SEAM(base + 6);
            if (IN(base + 7)) { { CTX(); phase_ret_out(c); } { CTX(); phase_dil(c, 2); } }
            SEAM(base + 7);
            if (IN(base + 8)) { CTX(); pg8::Gemm g{WSP(bf16, WS_CAT), (const bf16*)(c.ws + WS_ABOUT + (size_t)jx * SZ_ABOUT), S_, D_, AB_OUT}; pg8::StaticOrder So; So.init(S_, D_, c.G, c.bid);
                pg8::EpiStore E{WSP(bf16, WS_Y), D_}; pg8::gemm_phase<pg8::EpiStore, pg8::StaticOrder, true, true>(c.lds, g, So, E, c.tid); }
            SEAM(base + 8);
        } else {
            if (IN(base + 3)) { CTX(); pg8::Gemm g{WSP(bf16, WS_H), (const bf16*)(c.ws + WS_CIN + (size_t)jx * SZ_CIN), S_, C_INP, D_}; pg8::StaticOrder So; So.init(S_, C_INP, c.G, c.bid);
                pg8::EpiStore E{WSP(bf16, WS_P), C_INP}; pg8::gemm_phase<pg8::EpiStore, pg8::StaticOrder, true, true>(c.lds, g, So, E, c.tid); }
            SEAM(base + 3);
            if (IN(base + 4)) { CTX(); phase_rope_odd(c); }
            SEAM(base + 4);
            if (IN(base + 5)) { { CTX(); phase_compress(c, jx); } { CTX(); phase_nsa_window(c); } }
            SEAM(base + 5);
            if (IN(base + 6)) { CTX(); phase_nsa_cmp(c); }
            SEAM(base + 6);
            if (IN(base + 7)) { CTX(); phase_nsa_sel(c); }
            SEAM(base + 7);
            if (IN(base + 8)) { CTX(); pg8::Gemm g{WSP(bf16, WS_CAT), (const bf16*)(c.ws + WS_COUT + (size_t)jx * SZ_COUT), S_, D_, C_OUT}; pg8::StaticOrder So; So.init(S_, D_, c.G, c.bid);
                pg8::EpiStore E{WSP(bf16, WS_Y), D_}; pg8::gemm_phase<pg8::EpiStore, pg8::StaticOrder, true, true>(c.lds, g, So, E, c.tid); }
            SEAM(base + 8);
        }
        if (IN(base + 9)) { CTX(); const float* ng = c.norm_g + (size_t)L * 6 * D_; phase_rowpass(c, ng + 3 * D_, 1.0f, ng + 4 * D_); }
        SEAM(base + 9);
        if (IN(base + 10)) { CTX(); pg8::Gemm g{WSP(bf16, WS_H), (const bf16*)(c.ws + WS_W13 + (size_t)(2 * L + 1) * SZ_W13), S_, NUP, D_}; pg8::StaticOrder So; So.init(S_, NUP, c.G, c.bid);
            pg8::EpiSwiglu E{WSP(bf16, WS_P), DFF}; pg8::gemm_phase<pg8::EpiSwiglu, pg8::StaticOrder, true, true>(c.lds, g, So, E, c.tid); }
        SEAM(base + 10);
        if (IN(base + 11)) { CTX(); pg8::Gemm g{WSP(bf16, WS_P), (const bf16*)(c.ws + WS_W2 + (size_t)(2 * L + 1) * SZ_W2), S_, D_, DFF}; pg8::StaticOrder So; So.init(S_, D_, c.G, c.bid);
            pg8::EpiStore E{WSP(bf16, WS_Y), D_}; pg8::gemm_phase<pg8::EpiStore, pg8::StaticOrder, true, true>(c.lds, g, So, E, c.tid); }
        SEAM(base + 11);
        if (IN(base + 12)) { CTX(); const float* ng = c.norm_g + (size_t)L * 6 * D_; phase_rowpass(c, ng + 5 * D_, 0.5f, (L + 1 < DEPTH) ? ng + 6 * D_ : nullptr); }
        if (L + 1 < DEPTH) SEAM(base + 12);
    }
#undef IN
#undef SEAM
}

extern "C" void kernel_launch(void* const* d_in, const int* in_sizes, int n_in, void* d_out, int out_size, void* d_ws, size_t ws_size, hipStream_t stream) {
    static int grid = 0;
    if (grid == 0) {
        if (n_in != 16 || in_sizes[0] != S_ * D_ || out_size != S_ * D_ || ws_size < WS_END) { fprintf(stderr, "kernel_launch: unexpected shapes/workspace (n_in %d, in0 %d, out %d, ws %zu < %zu)\n", n_in, n_in > 0 ? in_sizes[0] : -1, out_size, ws_size, (size_t)WS_END); grid = -1; return; }
        int dev = 0, cus = 0;
        if (hipGetDevice(&dev) != hipSuccess || hipDeviceGetAttribute(&cus, hipDeviceAttributeMultiprocessorCount, dev) != hipSuccess) { grid = -1; return; }
        if (hipFuncSetAttribute((const void*)mk_fwd, hipFuncAttributeMaxDynamicSharedMemorySize, LDS_BYTES) != hipSuccess) { fprintf(stderr, "kernel_launch: hipFuncSetAttribute failed\n"); grid = -1; return; }
        int per_cu = 0;
        if (hipOccupancyMaxActiveBlocksPerMultiprocessor(&per_cu, (const void*)mk_fwd, NTHREADS, LDS_BYTES) != hipSuccess || per_cu < 1) fprintf(stderr, "kernel_launch: occupancy query says %d\n", per_cu);
        (void)hipGetLastError();
        grid = cus;
    }
    if (grid < 0) return;
    (void)hipMemsetAsync((char*)d_ws + WS_CTL, 0, CTL_ZERO_BYTES, stream);
    Args a{};
    for (int i = 0; i < 16; ++i) a.in[i] = (const float*)d_in[i];
    a.out = (float*)d_out; a.ws = (unsigned char*)d_ws;
#if MK_FUSED
    a.ph_lo = 0; a.ph_hi = N_PHASES;
    hipLaunchKernelGGL(mk_fwd, dim3(grid), dim3(NTHREADS), LDS_BYTES, stream, a);
#else
    for (int p = 0; p < N_PHASES; ++p) {
        a.ph_lo = p; a.ph_hi = p + 1;
        hipLaunchKernelGGL(mk_fwd, dim3(grid), dim3(NTHREADS), LDS_BYTES, stream, a);
    }
#endif
}
```

```cpp
#include <hip/hip_runtime.h>
#include <cstdio>
#include <cstdint>
namespace pg8 {
#define PG8_LAS __attribute__((address_space(3)))
typedef unsigned short bf16_t;
typedef short bf16x8 __attribute__((ext_vector_type(8)));
typedef float f32x4 __attribute__((ext_vector_type(4)));
typedef unsigned u32x4 __attribute__((ext_vector_type(4)));
constexpr int BM = 256, BK = 64, HALF = 128, HTB = HALF * BK * 2  , STAGE_BYTES = 8 * HTB, NXCD = 8, WGM = 8;

__host__ __device__ __forceinline__ int lds_byte(int r, int c) { const int st = (r >> 4) * 2 + (c >> 5), rr = r & 15, cc = c & 31, ob = rr * 64 + cc * 2; return st * 1024 + (ob ^ (((ob >> 9) & 1) << 5)); }
__host__ __device__ __forceinline__ void stage_rc(int b, int& R, int& C) { const int st = b / 1024, sb = b % 1024, swz = sb ^ (((sb >> 9) & 1) << 5); R = (st >> 1) * 16 + swz / 64; C = (st & 1) * 32 + (swz % 64) / 2; }
__host__ __device__ __forceinline__ int perm32(int rho) { const int n = rho >> 4, i = rho & 15; return 8 * (i >> 2) + 4 * n + (i & 3); }

struct Unit { int pm, pn; };
struct Gemm { const bf16_t* A; const bf16_t* Bt; int M, N, K; };

struct StaticOrder {
    int nM, nN, nwg, G, c;
    __host__ __device__ void init(int M, int N, int G_, int c_) { nM = M / BM; nN = N / BM; nwg = nM * nN; G = G_; c = c_; }
    __host__ __device__ bool next(int i, Unit& u) const {
        const long L = (long)i * G + c; if (L >= nwg) return false;
        int wgid = (int)L; { const int q = nwg / NXCD, r = nwg % NXCD, xcd = wgid % NXCD, off = wgid / NXCD; wgid = (xcd < r ? xcd * (q + 1) : r * (q + 1) + (xcd - r) * q) + off; }
        const int nig = WGM * nN, gid = wgid / nig, fm = gid * WGM, gsz = (nM - fm) < WGM ? (nM - fm) : WGM;
        u.pm = fm + ((wgid % nig) % gsz); u.pn = (wgid % nig) / gsz; return true;
    }
    __device__ __forceinline__ void a_ready(const Unit&) const {}
    __device__ __forceinline__ void done(const Unit&) const {}
};

__device__ __forceinline__ unsigned cvt_pk_bf16(float lo, float hi) { unsigned r; asm volatile("v_cvt_pk_bf16_f32 %0, %1, %2" : "=v"(r) : "v"(lo), "v"(hi)); return r; }
struct EpiStore {
    static constexpr bool PERM = true, AFTER_DRAIN = false;
    bf16_t* O; int ldc;
    __device__ __forceinline__ void operator()(const f32x4 (&acc)[2][2][4][2], const Unit& u, int wr, int wc, int fr, int fq) const {
        const int row0 = u.pm * BM + wr * 64 + fr, col0 = u.pn * BM + wc * 32 + 8 * fq;
#pragma unroll
        for (int ai = 0; ai < 2; ++ai)
#pragma unroll
            for (int m = 0; m < 4; ++m) { bf16_t* rowp = O + (size_t)(row0 + ai * HALF + m * 16) * ldc + col0;
#pragma unroll
                for (int bj = 0; bj < 2; ++bj) { const f32x4 v0 = acc[ai][bj][m][0], v1 = acc[ai][bj][m][1];
                    u32x4 w; w.x = cvt_pk_bf16(v0[0], v0[1]); w.y = cvt_pk_bf16(v0[2], v0[3]); w.z = cvt_pk_bf16(v1[0], v1[1]); w.w = cvt_pk_bf16(v1[2], v1[3]);
                    *(u32x4*)(rowp + bj * HALF) = w; } }
    }
};
__device__ __forceinline__ float silu_f(float a) { return a * __builtin_amdgcn_rcpf(1.0f + __expf(-a)); }
struct EpiSwiglu {
    static constexpr bool PERM = true, AFTER_DRAIN = false;
    bf16_t* O; int ldc;
    __device__ __forceinline__ void operator()(const f32x4 (&acc)[2][2][4][2], const Unit& u, int wr, int wc, int fr, int fq) const {
        const int row0 = u.pm * BM + wr * 64 + fr, col0 = u.pn * HALF + wc * 32 + 8 * fq;
#pragma unroll
        for (int ai = 0; ai < 2; ++ai)
#pragma unroll
            for (int m = 0; m < 4; ++m) { bf16_t* rowp = O + (size_t)(row0 + ai * HALF + m * 16) * ldc + col0;
                const f32x4 a0 = acc[ai][0][m][0], a1 = acc[ai][0][m][1], b0 = acc[ai][1][m][0], b1 = acc[ai][1][m][1];
                u32x4 w; w.x = cvt_pk_bf16(silu_f(a0[0]) * b0[0], silu_f(a0[1]) * b0[1]); w.y = cvt_pk_bf16(silu_f(a0[2]) * b0[2], silu_f(a0[3]) * b0[3]);
                w.z = cvt_pk_bf16(silu_f(a1[0]) * b1[0], silu_f(a1[1]) * b1[1]); w.w = cvt_pk_bf16(silu_f(a1[2]) * b1[2], silu_f(a1[3]) * b1[3]);
                *(u32x4*)rowp = w; }
    }
};

template <class Epi, class Sched, bool ALIGN_EPI = false, bool SP2 = false>
__device__ __forceinline__ void gemm_phase(PG8_LAS unsigned char* lds, const Gemm g, const Sched& S, const Epi& E, int tid_in) {
    int tid_l = tid_in; asm volatile("" : "+v"(tid_l));
    const int tid = tid_l, wid = __builtin_amdgcn_readfirstlane(tid >> 6), lane = tid & 63, wr = wid >> 2, wc = wid & 3, fr = lane & 15, fq = lane >> 4;
    const int K = g.K, nt = K / BK;
    unsigned voffA[2], voffB[2];
#pragma unroll
    for (int i = 0; i < 2; ++i) { int R, C; stage_rc(tid * 16 + i * 8192, R, C); const int Rb = Epi::PERM ? ((R & ~31) + perm32(R & 31)) : R;
        voffA[i] = (unsigned)(R * K + C) * 2u; voffB[i] = (unsigned)(Rb * K + C) * 2u; }
    const size_t kstep = (size_t)(BK * 2);
    const size_t hstep = (size_t)HALF * K * 2;
    const size_t tstep = 2 * hstep;
    const unsigned ldsw = (unsigned)wid * 1024u;
    const int aoff = lds_byte(wr * 64 + fr, fq * 8), boff = lds_byte(wc * 32 + fr, fq * 8);
#define PG8_SA(b, h) (((b) * 2 + (h)) * HTB)
#define PG8_SB(b, h) ((4 + (b) * 2 + (h)) * HTB)
#define PG8_STAGE(bufoff, gbase, voff) do { _Pragma("unroll") for (int _i = 0; _i < 2; ++_i) \
        __builtin_amdgcn_global_load_lds((const unsigned*)((const char*)(gbase) + (voff)[_i]), (PG8_LAS unsigned*)(lds + (bufoff) + ldsw + _i * 8192), 16, 0, 0); } while (0)
#define PG8_LDA(dst, b, h) do { _Pragma("unroll") for (int m = 0; m < 4; ++m) _Pragma("unroll") for (int k = 0; k < 2; ++k) dst[m][k] = *(const PG8_LAS bf16x8*)(lds + PG8_SA(b, h) + aoff + m * 2048 + k * 1024); } while (0)
#define PG8_LDB(dst, b, h) do { _Pragma("unroll") for (int n = 0; n < 2; ++n) _Pragma("unroll") for (int k = 0; k < 2; ++k) dst[n][k] = *(const PG8_LAS bf16x8*)(lds + PG8_SB(b, h) + boff + n * 2048 + k * 1024); } while (0)
#define PG8_MMA(ai, bj, At, Bt) do { __builtin_amdgcn_s_setprio(1); _Pragma("unroll") for (int m = 0; m < 4; ++m) _Pragma("unroll") for (int n = 0; n < 2; ++n) _Pragma("unroll") for (int k = 0; k < 2; ++k) \
        acc[ai][bj][m][n] = __builtin_amdgcn_mfma_f32_16x16x32_bf16(Bt[n][k], At[m][k], acc[ai][bj][m][n], 0, 0, 0); __builtin_amdgcn_s_setprio(0); } while (0)
#define PG8_WAIT_V(n) asm volatile("s_waitcnt vmcnt(" #n ")" ::: "memory")
#define PG8_WAIT_L(n) asm volatile("s_waitcnt lgkmcnt(" #n ")" ::: "memory")
#define PG8_BAR __builtin_amdgcn_s_barrier()
#define PG8_SCHED __builtin_amdgcn_sched_barrier(0)
    Unit cur, nxt; int ui = 0;
    if (!S.next(0, cur)) return;
    f32x4 acc[2][2][4][2];
#pragma unroll
    for (int a = 0; a < 2; ++a)
#pragma unroll
        for (int b = 0; b < 2; ++b)
#pragma unroll
            for (int m = 0; m < 4; ++m)
#pragma unroll
                for (int n = 0; n < 2; ++n) acc[a][b][m][n] = (f32x4){0.f, 0.f, 0.f, 0.f};
    bf16x8 At[4][2], B0[2][2], B1[2][2];
    const char* cA = (const char*)g.A + (size_t)cur.pm * tstep; const char* cB = (const char*)g.Bt + (size_t)cur.pn * tstep;
    S.a_ready(cur);
    if constexpr (SP2) {
        PG8_STAGE(PG8_SB(0, 0), cB, voffB); PG8_STAGE(PG8_SB(0, 1), cB + hstep, voffB); PG8_STAGE(PG8_SA(0, 0), cA, voffA); PG8_STAGE(PG8_SA(0, 1), cA + hstep, voffA);
        if (wr == 1) PG8_BAR;
        PG8_WAIT_V(2); PG8_BAR;
        PG8_STAGE(PG8_SB(1, 0), cB + kstep, voffB); PG8_STAGE(PG8_SA(1, 0), cA + kstep, voffA); PG8_STAGE(PG8_SB(1, 1), cB + hstep + kstep, voffB);
        PG8_WAIT_V(6); PG8_BAR;
    } else {
        PG8_STAGE(PG8_SB(0, 0), cB, voffB); PG8_STAGE(PG8_SA(0, 0), cA, voffA); PG8_STAGE(PG8_SB(0, 1), cB + hstep, voffB); PG8_STAGE(PG8_SA(0, 1), cA + hstep, voffA);
        if (wr == 1) PG8_BAR;
        PG8_WAIT_V(4); PG8_BAR;
        PG8_STAGE(PG8_SB(1, 0), cB + kstep, voffB); PG8_STAGE(PG8_SA(1, 0), cA + kstep, voffA); PG8_STAGE(PG8_SB(1, 1), cB + hstep + kstep, voffB);
        PG8_WAIT_V(6); PG8_BAR;
    }
    for (;;) {
        const bool has_next = S.next(ui + 1, nxt);
        const char* nA = has_next ? (const char*)g.A + (size_t)nxt.pm * tstep : cA; const char* nB = has_next ? (const char*)g.Bt + (size_t)nxt.pn * tstep : cB;
        for (int t = 0; t < nt; t += 2) {
            const bool last = (t == nt - 2);
            const char* a1 = cA + (size_t)(t + 1) * kstep;
            const char* a2 = last ? nA : cA + (size_t)(t + 2) * kstep; const char* b2 = last ? nB : cB + (size_t)(t + 2) * kstep;
            const char* a3 = a2 + kstep; const char* b3 = b2 + kstep;
            if (last && has_next) S.a_ready(nxt);
            if constexpr (SP2) {
            PG8_LDB(B0, 0, 0); PG8_LDB(B1, 0, 1); PG8_SCHED; PG8_LDA(At, 0, 0); PG8_STAGE(PG8_SA(1, 1), a1 + hstep, voffA);
            PG8_WAIT_V(8); PG8_WAIT_L(0); PG8_BAR; PG8_MMA(0, 0, At, B0); PG8_MMA(0, 1, At, B1); PG8_BAR; PG8_SCHED;
            PG8_LDA(At, 0, 1); PG8_STAGE(PG8_SB(0, 0), b2, voffB); PG8_STAGE(PG8_SB(0, 1), b2 + hstep, voffB); PG8_STAGE(PG8_SA(0, 0), a2, voffA);
            PG8_WAIT_V(8); PG8_WAIT_L(0); PG8_BAR; PG8_MMA(1, 0, At, B0); PG8_MMA(1, 1, At, B1); PG8_BAR; PG8_SCHED;
            PG8_LDB(B0, 1, 0); PG8_LDB(B1, 1, 1); PG8_SCHED; PG8_LDA(At, 1, 0); PG8_STAGE(PG8_SA(0, 1), a2 + hstep, voffA);
            PG8_WAIT_V(8); PG8_WAIT_L(0); PG8_BAR; PG8_MMA(0, 0, At, B0); PG8_MMA(0, 1, At, B1); PG8_BAR; PG8_SCHED;
            PG8_LDA(At, 1, 1); PG8_STAGE(PG8_SB(1, 0), b3, voffB); PG8_STAGE(PG8_SB(1, 1), b3 + hstep, voffB); PG8_STAGE(PG8_SA(1, 0), a3, voffA);
            PG8_WAIT_V(8); PG8_WAIT_L(0); PG8_BAR; PG8_MMA(1, 0, At, B0); PG8_MMA(1, 1, At, B1); PG8_BAR; PG8_SCHED;
            } else {
            PG8_LDB(B0, 0, 0); PG8_SCHED; PG8_LDA(At, 0, 0); PG8_STAGE(PG8_SA(1, 1), a1 + hstep, voffA);
            PG8_WAIT_L(8); PG8_BAR; PG8_WAIT_L(0); PG8_MMA(0, 0, At, B0); PG8_BAR; PG8_SCHED;
            PG8_LDB(B1, 0, 1); PG8_STAGE(PG8_SB(0, 0), b2, voffB);
            PG8_BAR; PG8_WAIT_L(0); PG8_MMA(0, 1, At, B1); PG8_BAR;
            PG8_LDA(At, 0, 1); PG8_STAGE(PG8_SA(0, 0), a2, voffA);
            PG8_BAR; PG8_WAIT_L(0); PG8_MMA(1, 0, At, B0); PG8_BAR; PG8_SCHED;
            PG8_STAGE(PG8_SB(0, 1), b2 + hstep, voffB);
            PG8_WAIT_V(6); PG8_BAR; PG8_MMA(1, 1, At, B1); PG8_BAR;
            PG8_LDB(B0, 1, 0); PG8_SCHED; PG8_LDA(At, 1, 0); PG8_STAGE(PG8_SA(0, 1), a2 + hstep, voffA);
            PG8_WAIT_L(8); PG8_BAR; PG8_WAIT_L(0); PG8_MMA(0, 0, At, B0); PG8_BAR; PG8_SCHED;
            PG8_LDB(B1, 1, 1); PG8_STAGE(PG8_SB(1, 0), b3, voffB);
            PG8_BAR; PG8_WAIT_L(0); PG8_MMA(0, 1, At, B1); PG8_BAR;
            PG8_LDA(At, 1, 1); PG8_STAGE(PG8_SA(1, 0), a3, voffA);
            PG8_BAR; PG8_WAIT_L(0); PG8_MMA(1, 0, At, B0); PG8_BAR; PG8_SCHED;
            PG8_STAGE(PG8_SB(1, 1), b3 + hstep, voffB);
            PG8_WAIT_V(6); PG8_BAR; PG8_MMA(1, 1, At, B1); PG8_BAR;
            }
        }
        if constexpr (ALIGN_EPI) { if (wr == 0) PG8_BAR; }
        if constexpr (!Epi::AFTER_DRAIN) { E(acc, cur, wr, wc, fr, fq); S.done(cur); }
        if (!has_next) break;
#pragma unroll
        for (int a = 0; a < 2; ++a)
#pragma unroll
            for (int b = 0; b < 2; ++b)
#pragma unroll
                for (int m = 0; m < 4; ++m)
#pragma unroll
                    for (int n = 0; n < 2; ++n) acc[a][b][m][n] = (f32x4){0.f, 0.f, 0.f, 0.f};
        cur = nxt; cA = nA; cB = nB; ++ui;
        if constexpr (ALIGN_EPI) { if (wr == 1) PG8_BAR; }
    }
    PG8_WAIT_V(0);
    if constexpr (!ALIGN_EPI) { if (wr == 0) PG8_BAR; }
    PG8_BAR;
    if constexpr (Epi::AFTER_DRAIN) { E.fused(acc, cur, wr, wc, fr, fq, lds, wid, lane); S.done(cur); }
#undef PG8_SA
#undef PG8_SB
#undef PG8_STAGE
#undef PG8_LDA
#undef PG8_LDB
#undef PG8_MMA
#undef PG8_WAIT_V
#undef PG8_WAIT_L
#undef PG8_BAR
#undef PG8_SCHED
}
}

constexpr int S_ = 8192, D_ = 2048, DFF = 5504, DEPTH = 4;
constexpr int AB_IN = 9216, AB_OUT = 3072, C_IN = 5168, C_INP = 5376, C_OUT = 2048;
constexpr int NUP = 2 * DFF;
constexpr float NORM_EPS = 1e-6f;
constexpr int NWAVES = 8, NTHREADS = 512;
#ifndef MK_FUSED
#define MK_FUSED 1
#endif
constexpr int N_PHASES = 1 + 13 * DEPTH;
#ifndef PROBE_DUP
#define PROBE_DUP 0
#endif

constexpr size_t MiB = 1u << 20;
constexpr size_t WS_CTL = 0, CTL_ZERO_BYTES = 1 * MiB;
constexpr size_t SZ_W13 = (size_t)NUP * D_ * 2, SZ_W2 = (size_t)D_ * DFF * 2, SZ_ABIN = (size_t)AB_IN * D_ * 2, SZ_ABOUT = (size_t)D_ * AB_OUT * 2, SZ_CIN = (size_t)C_INP * D_ * 2, SZ_COUT = (size_t)D_ * C_OUT * 2;
constexpr size_t WS_W13 = 2 * MiB, WS_W2 = WS_W13 + 8 * SZ_W13, WS_ABIN = WS_W2 + 8 * SZ_W2, WS_ABOUT = WS_ABIN + 2 * SZ_ABIN, WS_CIN = WS_ABOUT + 2 * SZ_ABOUT, WS_COUT = WS_CIN + 2 * SZ_CIN;
constexpr size_t WS_H = WS_COUT + 2 * SZ_COUT;
constexpr size_t WS_Y = WS_H + (size_t)S_ * D_ * 2;
constexpr size_t WS_CAT = WS_Y + (size_t)S_ * D_ * 2;
constexpr size_t WS_P = WS_CAT + (size_t)S_ * AB_OUT * 2;
constexpr size_t WS_KV = WS_P + (size_t)S_ * AB_IN * 2;
constexpr size_t WS_PREV = WS_KV + (size_t)8 * 64 * 128 * 256 * 4;
constexpr size_t WS_CK = WS_PREV + (size_t)8 * 64 * 128 * 256 * 4;
constexpr size_t WS_CV = WS_CK + (size_t)4 * 512 * 128 * 4;
constexpr size_t WS_OACC = WS_CV + (size_t)4 * 512 * 128 * 4;
constexpr size_t WS_BM = WS_OACC + (size_t)S_ * C_OUT * 2;
constexpr size_t WS_DST = WS_BM + (size_t)4 * S_ * 4 * 4;
constexpr size_t WS_CW1 = WS_DST + ((size_t)S_ * 1024 + (size_t)S_ * 16) * 4;
constexpr size_t WS_CW2 = WS_CW1 + (size_t)4 * 256 * 4096 * 2;
constexpr size_t WS_CB1 = WS_CW2 + (size_t)4 * 128 * 256 * 2;
constexpr size_t WS_END = WS_CB1 + (size_t)4 * 256 * 4;
static_assert(WS_W13 % 256 == 0 && WS_W2 % 256 == 0 && WS_H % 256 == 0 && WS_P % 256 == 0 && WS_KV % 256 == 0, "alignment");

constexpr int CW_BAR = 4096;
constexpr int RING_BYTES = 131072, MISC_OFF = RING_BYTES + 320, LDS_BYTES = 147456;

#define GAS __attribute__((address_space(1)))
#define LAS __attribute__((address_space(3)))
typedef unsigned short bf16;
typedef unsigned v4u __attribute__((ext_vector_type(4)));
typedef unsigned v2u __attribute__((ext_vector_type(2)));
typedef float f32x4 __attribute__((ext_vector_type(4)));
typedef float f32x2 __attribute__((ext_vector_type(2)));
#define LDS_WAIT() asm volatile("s_waitcnt lgkmcnt(0)" ::: "memory")
__device__ __forceinline__ unsigned f2bf(float f) { unsigned u = __builtin_bit_cast(unsigned, f); return (u + 0x7fffu + ((u >> 16) & 1u)) >> 16; }
__device__ __forceinline__ unsigned pk2(float lo, float hi) { return f2bf(lo) | (f2bf(hi) << 16); }
__device__ __forceinline__ float bflo(unsigned w) { return __builtin_bit_cast(float, w << 16); }
__device__ __forceinline__ float bfhi(unsigned w) { return __builtin_bit_cast(float, w & 0xffff0000u); }
__device__ __forceinline__ float bf2f(bf16 b) { return __builtin_bit_cast(float, (unsigned)b << 16); }
__device__ __forceinline__ float wave_sum(float v) {
#pragma unroll
    for (int o = 1; o < 64; o <<= 1) v += __shfl_xor(v, o);
    return v;
}
__device__ __forceinline__ float wave_max(float v) {
#pragma unroll
    for (int o = 1; o < 64; o <<= 1) v = fmaxf(v, __shfl_xor(v, o));
    return v;
}
__device__ __forceinline__ float rdlane(float v, int j) { return __builtin_bit_cast(float, __builtin_amdgcn_readlane(__builtin_bit_cast(int, v), j)); }

#define XB_TMO      128
#define XB_XCNT(j)  (256  + 64 * (j))
#define XB_XSUB(j)  (1280 + 64 * (j))
#define XB_XGEN(j)  (2304 + 64 * (j))
#define XB_TOP      3328
#define XB_TOPGEN   3392
#define XCD_BAR_WORDS 3456
#define XB_SPIN_CAP (1u << 18)

__device__ __forceinline__ unsigned xb_ld(unsigned* p)              { return __hip_atomic_load(p, __ATOMIC_RELAXED, __HIP_MEMORY_SCOPE_AGENT); }
__device__ __forceinline__ unsigned xb_add(unsigned* p, unsigned v) { return __hip_atomic_fetch_add(p, v, __ATOMIC_RELAXED, __HIP_MEMORY_SCOPE_AGENT); }
__device__ __forceinline__ unsigned xb_xcc_id() { return (unsigned)__builtin_amdgcn_s_getreg((3 << 11) | 20) & 0xFu; }
#define XB_SPIN(cond, bar) do { unsigned _sp = 0; while (cond) { __builtin_amdgcn_s_sleep(1); \
    if ((++_sp & 255u) == 0u) { if (xb_ld(&(bar)[XB_TMO])) break; if (_sp > XB_SPIN_CAP) { atomicAdd(&(bar)[XB_TMO], 1u); break; } } } } while (0)

struct XcdBarrier {
    unsigned* bar; unsigned x;
    volatile LAS unsigned* st;
};

__device__ __forceinline__ XcdBarrier xcd_barrier_post(unsigned* bar, volatile LAS unsigned* st) {
    XcdBarrier b; b.bar = bar; b.x = xb_xcc_id(); b.st = st;
    if (threadIdx.x == 0) (void)xb_add(&bar[XB_XCNT(b.x)], 1u);
    return b;
}
__device__ __forceinline__ void xcd_barrier_complete(unsigned* bar, unsigned x, unsigned& nloc, unsigned& nx) {
    const unsigned G = gridDim.x * gridDim.y * gridDim.z;
    unsigned sum, cnt, mine, sp = 0u;
    for (;;) {
        sum = 0u; cnt = 0u; mine = 0u;
#pragma unroll
        for (unsigned j = 0; j < 16; ++j) { const unsigned c = xb_ld(&bar[XB_XCNT(j)]); sum += c; cnt += (c > 0u) ? 1u : 0u; mine = (j == x) ? c : mine; }
        if (sum == G) break;
        __builtin_amdgcn_s_sleep(1);
        if ((++sp & 255u) == 0u) { if (xb_ld(&bar[XB_TMO])) break; if (sp > XB_SPIN_CAP) { atomicAdd(&bar[XB_TMO], 1u); break; } }
    }
    nloc = mine > 0u ? mine : 1u; nx = cnt > 0u ? cnt : 1u;
}

__device__ __forceinline__ void xcd_barrier(const XcdBarrier& b) {
    asm volatile("s_waitcnt vmcnt(0)" ::: "memory");
    __syncthreads();
    if (threadIdx.x == 0) {
        unsigned* bar = b.bar;
        __builtin_amdgcn_s_waitcnt(0);
        unsigned nloc = b.st[0], nx = b.st[1];
        if (nloc == 0u) { xcd_barrier_complete(bar, b.x, nloc, nx); b.st[0] = nloc; b.st[1] = nx; }
        const unsigned old = xb_add(&bar[XB_XSUB(b.x)], 1u);
        const unsigned gen = old / nloc;
        if (old + 1u == (gen + 1u) * nloc) {
            __builtin_amdgcn_fence(__ATOMIC_RELEASE, "agent");
            asm volatile("s_waitcnt vmcnt(0)" ::: "memory");
            const unsigned og = xb_add(&bar[XB_TOP], 1u);
            const unsigned tg = og / nx;
            if (og + 1u == (tg + 1u) * nx) xb_add(&bar[XB_TOPGEN], 1u);
            else XB_SPIN(xb_ld(&bar[XB_TOPGEN]) == tg, bar);
            __builtin_amdgcn_fence(__ATOMIC_ACQUIRE, "agent");
            xb_add(&bar[XB_XGEN(b.x)], 1u);
            asm volatile("s_waitcnt vmcnt(0)" ::: "memory");
        } else {
            XB_SPIN(xb_ld(&bar[XB_XGEN(b.x)]) == gen, bar);
            __builtin_amdgcn_fence(__ATOMIC_ACQUIRE, "agent");
            asm volatile("s_waitcnt vmcnt(0)" ::: "memory");
        }
    }
    __syncthreads();
}

struct Ctx {
    const float* x; const int* pos; const float* norm_g; const float *w1, *w3, *w2, *ab_in, *ab_out, *c_in, *c_out, *ck_w1, *ck_w2, *cv_w1, *cv_w2, *pe_k, *pe_v;
    float* out; unsigned char* ws;
    int tid, lane, wave, bid, G, gw, NGW;
    LAS unsigned char* lds;
};

__device__ __forceinline__ void transpose_item(const float* W, int K, int N, bf16* WT, int dst_row0, LAS float* scr, int k0, int n0, int lane) {
#pragma unroll
    for (int i = 0; i < 32; ++i) { const int kk = 2 * i + (lane >> 5); const int n = n0 + (lane & 31); scr[kk * 33 + (lane & 31)] = (n < N) ? W[(size_t)(k0 + kk) * N + n] : 0.f; }
    LDS_WAIT();
    const int c = lane & 7;
#pragma unroll
    for (int j = 0; j < 4; ++j) { const int nl = (lane >> 3) + 8 * j; const LAS float* s = scr + (8 * c) * 33 + nl;
        v4u o; o.x = pk2(s[0 * 33], s[1 * 33]); o.y = pk2(s[2 * 33], s[3 * 33]); o.z = pk2(s[4 * 33], s[5 * 33]); o.w = pk2(s[6 * 33], s[7 * 33]);
        *(v4u*)(WT + (size_t)(dst_row0 + nl) * K + k0 + 8 * c) = o; }
    LDS_WAIT();
}
__device__ __forceinline__ void phase_prologue(const Ctx& c) {
    LAS float* scr = (LAS float*)(c.lds + c.wave * 16384);
    constexpr int I13 = (D_ / 64) * (DFF / 32), I2 = (DFF / 64) * (D_ / 32), IABI = (D_ / 64) * (AB_IN / 32), IABO = (AB_OUT / 64) * (D_ / 32), ICI = (D_ / 64) * (C_INP / 32), ICO = (C_OUT / 64) * (D_ / 32);
    constexpr int NFFN = 24 * I13;
    static_assert(I13 == I2, "ffn item counts");
    constexpr int NITEMS = NFFN + 2 * (IABI + IABO + ICI + ICO);
    for (int it = c.gw; it < NITEMS; it += c.NGW) {
        if (it < NFFN) {
            const int mat = it / I13, r = it % I13, lf = mat / 3, which = mat % 3;
            if (which < 2) { const int nblk = DFF / 32, kb = r / nblk, nb = r % nblk, n0 = 32 * nb;
                const float* W = (which == 0 ? c.w1 : c.w3) + (size_t)lf * D_ * DFF;
                bf16* WT = (bf16*)(c.ws + WS_W13 + (size_t)lf * SZ_W13);
                transpose_item(W, D_, DFF, WT, 256 * (n0 / 128) + (n0 % 128) + 128 * which, scr, 64 * kb, n0, c.lane);
            } else { const int nblk = D_ / 32, kb = r / nblk, nb = r % nblk;
                transpose_item(c.w2 + (size_t)lf * DFF * D_, DFF, D_, (bf16*)(c.ws + WS_W2 + (size_t)lf * SZ_W2), 32 * nb, scr, 64 * kb, 32 * nb, c.lane); }
            continue;
        }
        int r = it - NFFN;
        const int j = r / (IABI + IABO + ICI + ICO); r = r % (IABI + IABO + ICI + ICO);
        if (r < IABI) { const int nblk = AB_IN / 32, kb = r / nblk, nb = r % nblk; transpose_item(c.ab_in + (size_t)j * D_ * AB_IN, D_, AB_IN, (bf16*)(c.ws + WS_ABIN + (size_t)j * SZ_ABIN), 32 * nb, scr, 64 * kb, 32 * nb, c.lane); continue; } r -= IABI;
        if (r < IABO) { const int nblk = D_ / 32, kb = r / nblk, nb = r % nblk; transpose_item(c.ab_out + (size_t)j * AB_OUT * D_, AB_OUT, D_, (bf16*)(c.ws + WS_ABOUT + (size_t)j * SZ_ABOUT), 32 * nb, scr, 64 * kb, 32 * nb, c.lane); continue; } r -= IABO;
        if (r < ICI) { const int nblk = C_INP / 32, kb = r / nblk, nb = r % nblk; transpose_item(c.c_in + (size_t)j * D_ * C_IN, D_, C_IN, (bf16*)(c.ws + WS_CIN + (size_t)j * SZ_CIN), 32 * nb, scr, 64 * kb, 32 * nb, c.lane); continue; } r -= ICI;
        { const int nblk = D_ / 32, kb = r / nblk, nb = r % nblk; transpose_item(c.c_out + (size_t)j * C_OUT * D_, C_OUT, D_, (bf16*)(c.ws + WS_COUT + (size_t)j * SZ_COUT), 32 * nb, scr, 64 * kb, 32 * nb, c.lane); }
    }
    for (int it = c.gw; it < 4 * 512 + 4 * 16 + 4 * 64; it += c.NGW) {
        if (it < 2048) { const int mt = it >> 9, r = it & 511, kb = r >> 3, nb = r & 7;
            transpose_item(((mt & 1) ? c.cv_w1 : c.ck_w1) + (size_t)(mt >> 1) * 4096 * 256, 4096, 256, (bf16*)(c.ws + WS_CW1) + (size_t)mt * 256 * 4096, 32 * nb, scr, 64 * kb, 32 * nb, c.lane); }
        else if (it < 2048 + 64) { const int r0 = it - 2048, mt = r0 >> 4, r = r0 & 15, kb = r >> 2, nb = r & 3;
            transpose_item(((mt & 1) ? c.cv_w2 : c.ck_w2) + (size_t)(mt >> 1) * 256 * 128, 256, 128, (bf16*)(c.ws + WS_CW2) + (size_t)mt * 128 * 256, 32 * nb, scr, 64 * kb, 32 * nb, c.lane); }
        else { const int r0 = it - 2048 - 64, mt = r0 >> 6, jq = r0 & 63;
            const float* w1 = ((mt & 1) ? c.cv_w1 : c.ck_w1) + (size_t)(mt >> 1) * 4096 * 256 + 4 * jq; const float* pe = ((mt & 1) ? c.pe_v : c.pe_k) + (size_t)(mt >> 1) * 4096;
            f32x4 a = (f32x4){0.f, 0.f, 0.f, 0.f};
#pragma unroll 4
            for (int i = 0; i < 64; ++i) { const int k = c.lane + 64 * i; a += *(const f32x4*)(w1 + (size_t)k * 256) * pe[k]; }
            a.x = wave_sum(a.x); a.y = wave_sum(a.y); a.z = wave_sum(a.z); a.w = wave_sum(a.w);
            if (c.lane == 0) *(f32x4*)((float*)(c.ws + WS_CB1) + mt * 256 + 4 * jq) = a; }
    }
    bf16* H = (bf16*)(c.ws + WS_H);
    for (int row = c.gw; row < S_; row += c.NGW) {
        const f32x4* xr = (const f32x4*)(c.x + (size_t)row * D_) + c.lane; f32x4* orow = (f32x4*)(c.out + (size_t)row * D_) + c.lane;
        f32x4 v[8]; float ss = 0.f;
#pragma unroll
        for (int j = 0; j < 8; ++j) { v[j] = xr[64 * j]; ss += (v[j].x * v[j].x + v[j].y * v[j].y) + (v[j].z * v[j].z + v[j].w * v[j].w); }
        const float rstd = 1.0f / sqrtf(wave_sum(ss) * (1.0f / D_) + NORM_EPS);
        v2u* h8 = (v2u*)(H + (size_t)row * D_) + c.lane;
#pragma unroll
        for (int j = 0; j < 8; ++j) { orow[64 * j] = v[j]; const f32x4 g = ((const f32x4*)c.norm_g)[c.lane + 64 * j];
            v2u o; o.x = pk2(v[j].x * rstd * g.x, v[j].y * rstd * g.y); o.y = pk2(v[j].z * rstd * g.z, v[j].w * rstd * g.w); h8[64 * j] = o; }
    }
}

__device__ __forceinline__ void phase_rowpass(const Ctx& c, const float* gpost, float coef, const float* gnext) {
    const bf16* Y = (const bf16*)(c.ws + WS_Y); bf16* H = (bf16*)(c.ws + WS_H);
    for (int row = c.gw; row < S_; row += c.NGW) {
        f32x4* xr = (f32x4*)(c.out + (size_t)row * D_) + c.lane; const v2u* yr = (const v2u*)(Y + (size_t)row * D_) + c.lane;
        f32x4 xv[8], yv[8]; float ss = 0.f;
#pragma unroll
        for (int j = 0; j < 8; ++j) { xv[j] = xr[64 * j]; const v2u w = yr[64 * j]; yv[j] = (f32x4){bflo(w.x), bfhi(w.x), bflo(w.y), bfhi(w.y)};
            ss += (yv[j].x * yv[j].x + yv[j].y * yv[j].y) + (yv[j].z * yv[j].z + yv[j].w * yv[j].w); }
        const float rstd = coef / sqrtf(wave_sum(ss) * (1.0f / D_) + NORM_EPS);
        float ss2 = 0.f;
#pragma unroll
        for (int j = 0; j < 8; ++j) { const f32x4 g = ((const f32x4*)gpost)[c.lane + 64 * j]; xv[j] = xv[j] + yv[j] * rstd * g; xr[64 * j] = xv[j];
            ss2 += (xv[j].x * xv[j].x + xv[j].y * xv[j].y) + (xv[j].z * xv[j].z + xv[j].w * xv[j].w); }
        if (gnext) {
            const float rstd2 = 1.0f / sqrtf(wave_sum(ss2) * (1.0f / D_) + NORM_EPS);
            v2u* h8 = (v2u*)(H + (size_t)row * D_) + c.lane;
#pragma unroll
            for (int j = 0; j < 8; ++j) { const f32x4 g = ((const f32x4*)gnext)[c.lane + 64 * j];
                v2u o; o.x = pk2(xv[j].x * rstd2 * g.x, xv[j].y * rstd2 * g.y); o.y = pk2(xv[j].z * rstd2 * g.z, xv[j].w * rstd2 * g.w); h8[64 * j] = o; }
        }
    }
}

__device__ __forceinline__ void sincos_ang(float ang, float& sn, float& cs) {
    double r = (double)ang * 0.15915494309189535; r -= floor(r); const float rf = (float)r;
    sn = __builtin_amdgcn_sinf(rf); cs = __builtin_amdgcn_cosf(rf);
}
__device__ __forceinline__ void rope_pair(bf16* p, int half, float sn, float cs) {
    const float x1 = bf2f(p[0]), x2 = bf2f(p[half]);
    p[0] = (bf16)f2bf(x1 * cs - x2 * sn); p[half] = (bf16)f2bf(x2 * cs + x1 * sn);
}
constexpr float LOG2_RET_BASE = 13.287712379549449f, LOG2_ROPE_THETA = 18.931568569324174f;
__device__ __forceinline__ void phase_rope_even(const Ctx& c) {
    bf16* P = (bf16*)(c.ws + WS_P);
    for (int t = c.gw; t < S_; t += c.NGW) {
        const float pos = (float)c.pos[t]; bf16* row = P + (size_t)t * AB_IN;
        { float sn, cs; sincos_ang(pos * exp2f(-(float)c.lane * (1.0f / 64.0f) * LOG2_RET_BASE), sn, cs);
#pragma unroll 4
          for (int cb = 0; cb < 16; ++cb) rope_pair(row + (cb >> 3) * 1024 + (cb & 7) * 128 + c.lane, 64, sn, cs); }
        { const int i = c.lane & 15; float sn, cs; sincos_ang(pos * exp2f(-(float)i * (1.0f / 16.0f) * LOG2_ROPE_THETA), sn, cs);
#pragma unroll
          for (int j = 0; j < 4; ++j) { const int cb = (c.lane >> 4) + 4 * j; rope_pair(row + 6144 + (cb >> 3) * 1024 + (cb & 7) * 128 + i, 16, sn, cs); } }
    }
}
__device__ __forceinline__ void phase_rope_odd(const Ctx& c) {
    bf16* P = (bf16*)(c.ws + WS_P);
    for (int t = c.gw; t < S_; t += c.NGW) {
        const float pos = (float)c.pos[t]; bf16* row = P + (size_t)t * C_INP;
        const int i = c.lane & 15; float sn, cs; sincos_ang(pos * exp2f(-(float)i * (1.0f / 16.0f) * LOG2_ROPE_THETA), sn, cs);
#pragma unroll
        for (int j = 0; j < 7; ++j) { const int cb = (c.lane >> 4) + 4 * j;
            const int col = cb < 16 ? cb * 128 : (cb < 20 ? 2048 + (cb - 16) * 128 : (cb < 24 ? 3072 + (cb - 20) * 128 : 4096 + (cb - 24) * 128));
            rope_pair(row + col + i, 16, sn, cs); }
    }
}

__device__ __forceinline__ float ret_log_gamma(int h) { const float x = __builtin_amdgcn_exp2f(-5.0f - (float)h);
    return -x * (1.0f + x * (0.5f + x * ((1.0f / 3.0f) + x * (0.25f + x * (0.2f + x * ((1.0f / 6.0f) + x * (1.0f / 7.0f))))))); }
constexpr float RET_SCALE = 0.08838834764831845f;
constexpr float ATT_C2 = 0.08838834764831845f * 1.4426950408889634f;

__device__ __forceinline__ float gelu_tanh(float x) { const float u = 0.7978845608028654f * (x + 0.044715f * x * x * x); const float t = 1.0f - 2.0f / (1.0f + __expf(2.0f * u)); return 0.5f * x * (1.0f + t); }
typedef short bf16x8 __attribute__((ext_vector_type(8)));
typedef short s16x4 __attribute__((ext_vector_type(4)));
__device__ __forceinline__ s16x4 vtr(const LAS unsigned char* p) { return __builtin_bit_cast(s16x4, __builtin_amdgcn_ds_read_tr16_b64_v4i16((LAS s16x4*)p)); }
__device__ __forceinline__ f32x4 mfma16(bf16x8 a, bf16x8 b, f32x4 c) { return __builtin_amdgcn_mfma_f32_16x16x32_bf16(a, b, c, 0, 0, 0); }
__device__ __forceinline__ int off_b(int row, int ch) { return 256 * row + 16 * (ch ^ (((row & 3) << 2) | ((row >> 2) & 3))); }
__device__ __forceinline__ unsigned cvtpk(float lo, float hi) { unsigned r; asm volatile("v_cvt_pk_bf16_f32 %0, %1, %2" : "=v"(r) : "v"(lo), "v"(hi)); return r; }
struct LaneGeo { int qi, g4; int koff[4]; int voff[8]; };
__device__ __forceinline__ LaneGeo lane_geo(int lane) {
    LaneGeo G; G.qi = lane & 15; G.g4 = lane >> 4;
    const int kx = ((G.qi & 3) << 2) | (G.qi >> 2);
#pragma unroll
    for (int ks = 0; ks < 4; ++ks) G.koff[ks] = 256 * G.qi + 16 * ((4 * ks + G.g4) ^ kx);
    const int q = G.qi >> 2, p = G.qi & 3, vx = (q << 2) | G.g4;
#pragma unroll
    for (int db = 0; db < 8; ++db) G.voff[db] = 256 * (4 * G.g4 + q) + 16 * ((2 * db + (p >> 1)) ^ vx) + 8 * (p & 1);
    return G;
}
template <class RP> __device__ __forceinline__ void tile_dma(LAS unsigned char* Kb, LAS unsigned char* Vb, const RP& rp, int wave, int lane) {
#pragma unroll
    for (int i = 0; i < 2; ++i) { const int p = wave + 8 * i, row = 4 * p + (lane >> 4), ch = (lane & 15) ^ (((row & 3) << 2) | ((row >> 2) & 3)); const bf16 *kp = nullptr, *vp = nullptr; rp(row, kp, vp);
        __builtin_amdgcn_global_load_lds((const unsigned*)(kp + 8 * ch), (LAS unsigned*)(Kb + 1024 * p), 16, 0, 0);
        __builtin_amdgcn_global_load_lds((const unsigned*)(vp + 8 * ch), (LAS unsigned*)(Vb + 1024 * p), 16, 0, 0); }
}
#define TILE_SYNC() do { asm volatile("s_waitcnt vmcnt(0)" ::: "memory"); __syncthreads(); } while (0)
#define KFRAG(kg, ks) (*(const LAS bf16x8*)(Kb + 4096 * (kg) + G.koff[ks]))
__device__ __forceinline__ void attn_qk(f32x4 (&s)[2][4], const LAS unsigned char* Kb, const LaneGeo& G, const bf16x8 (&qf)[2][4]) {
    bf16x8 ka[4], kn[4];
#pragma unroll
    for (int ks = 0; ks < 4; ++ks) ka[ks] = KFRAG(0, ks);
#pragma unroll
    for (int kg = 0; kg < 4; ++kg) {
        if (kg < 3) {
#pragma unroll
            for (int ks = 0; ks < 4; ++ks) kn[ks] = KFRAG(kg + 1, ks); }
        asm volatile("" ::: "memory");
        s[0][kg] = (f32x4){0.f, 0.f, 0.f, 0.f}; s[1][kg] = (f32x4){0.f, 0.f, 0.f, 0.f};
#pragma unroll
        for (int ks = 0; ks < 4; ++ks) { s[0][kg] = mfma16(ka[ks], qf[0][ks], s[0][kg]); s[1][kg] = mfma16(ka[ks], qf[1][ks], s[1][kg]); }
#pragma unroll
        for (int ks = 0; ks < 4; ++ks) ka[ks] = kn[ks];
    }
}
template <class MaskF> __device__ __forceinline__ void attn_scores(f32x4 (&s)[2][4], const LAS unsigned char* Kb, const LaneGeo& G, const bf16x8 (&qf)[2][4], bool need_mask, const MaskF& mask) {
    attn_qk(s, Kb, G, qf);
#pragma unroll
    for (int qg = 0; qg < 2; ++qg)
#pragma unroll
        for (int kg = 0; kg < 4; ++kg)
#pragma unroll
            for (int r = 0; r < 4; ++r) { float v = s[qg][kg][r] * ATT_C2; if (need_mask && !mask(qg, 16 * kg + 4 * G.g4 + r)) v = -__builtin_inff(); s[qg][kg][r] = v; }
}
template <class MaskF> __device__ __forceinline__ void attn_tile(const LAS unsigned char* Kb, const LAS unsigned char* Vb, const LaneGeo& G, const bf16x8 (&qf)[2][4],
                                                                 float (&m)[2], float (&l)[2], f32x4 (&o)[2][8], bool need_mask, const MaskF& mask) {
    f32x4 s[2][4];
    attn_qk(s, Kb, G, qf);
    bf16x8 pb[2][2];
#pragma unroll
    for (int qg = 0; qg < 2; ++qg) {
        if (need_mask) {
#pragma unroll
            for (int kg = 0; kg < 4; ++kg)
#pragma unroll
                for (int r = 0; r < 4; ++r) if (!mask(qg, 16 * kg + 4 * G.g4 + r)) s[qg][kg][r] = -__builtin_inff(); }
        float mx = -__builtin_inff();
#pragma unroll
        for (int kg = 0; kg < 4; ++kg) mx = fmaxf(mx, fmaxf(fmaxf(s[qg][kg][0], s[qg][kg][1]), fmaxf(s[qg][kg][2], s[qg][kg][3])));
        mx = fmaxf(mx, __shfl_xor(mx, 16)); mx = fmaxf(mx, __shfl_xor(mx, 32));
        const float mn = fmaxf(m[qg], mx * ATT_C2);
        if (!__all(mn == m[qg])) {
            const float alpha = __builtin_amdgcn_exp2f(m[qg] - mn); m[qg] = mn; l[qg] *= alpha;
#pragma unroll
            for (int db = 0; db < 8; ++db) o[qg][db] *= alpha; }
        float ps = 0.f;
#pragma unroll
        for (int kg = 0; kg < 4; ++kg)
#pragma unroll
            for (int r = 0; r < 4; ++r) { const float p = __builtin_amdgcn_exp2f(__builtin_fmaf(s[qg][kg][r], ATT_C2, -mn)); s[qg][kg][r] = p; ps += p; }
        l[qg] += ps;
#pragma unroll
        for (int k2 = 0; k2 < 2; ++k2) { v4u w; w.x = cvtpk(s[qg][2 * k2][0], s[qg][2 * k2][1]); w.y = cvtpk(s[qg][2 * k2][2], s[qg][2 * k2][3]);
            w.z = cvtpk(s[qg][2 * k2 + 1][0], s[qg][2 * k2 + 1][1]); w.w = cvtpk(s[qg][2 * k2 + 1][2], s[qg][2 * k2 + 1][3]); pb[qg][k2] = __builtin_bit_cast(bf16x8, w); }
    }
#define VFRAG(i) __builtin_shufflevector(vtr(Vb + 8192 * ((i) >> 3) + G.voff[(i) & 7]), vtr(Vb + 8192 * ((i) >> 3) + 4096 + G.voff[(i) & 7]), 0, 1, 2, 3, 4, 5, 6, 7)
    bf16x8 va = VFRAG(0), vb2 = VFRAG(1);
#pragma unroll
    for (int i = 0; i < 16; ++i) {
        bf16x8 vn = va; if (i + 2 < 16) vn = VFRAG(i + 2);
        asm volatile("" ::: "memory");
        o[0][i & 7] = mfma16(va, pb[0][i >> 3], o[0][i & 7]); o[1][i & 7] = mfma16(va, pb[1][i >> 3], o[1][i & 7]);
        va = vb2; vb2 = vn;
    }
#undef VFRAG
}
#undef KFRAG
__device__ __forceinline__ float sigmoid_f(float x) { return 1.0f / (1.0f + __expf(-x)); }
constexpr int ATT_K0 = 0, ATT_K1 = 16384, ATT_V0 = 32768, ATT_V1 = 49152, ATT_X = 65536;

__device__ __forceinline__ void phase_compress(const Ctx& c, int jx) {
    const bf16* P = (const bf16*)(c.ws + WS_P);
    const int qi = c.lane & 15, g4 = c.lane >> 4;
    LAS unsigned char* Hs = c.lds;
    for (int u = c.bid; u < 256; u += c.G) {
        const int tensor = u >> 7, g = (u >> 5) & 3, n0 = 16 * (u & 31), mt = jx * 2 + tensor;
        const bf16* W1T = (const bf16*)(c.ws + WS_CW1) + (size_t)mt * 256 * 4096; const bf16* W2T = (const bf16*)(c.ws + WS_CW2) + (size_t)mt * 128 * 256; const float* B1 = (const float*)(c.ws + WS_CB1) + mt * 256;
        const bf16* xrow = P + (size_t)(16 * (n0 + qi)) * C_INP + (tensor ? 2560 : 2048) + g * 128 + 8 * g4;
        const bf16* wrow0 = W1T + (size_t)(32 * c.wave + qi) * 4096 + 8 * g4; const bf16* wrow1 = wrow0 + 16 * 4096;
        f32x4 a0 = (f32x4){0.f, 0.f, 0.f, 0.f}, a1 = (f32x4){0.f, 0.f, 0.f, 0.f};
#pragma unroll 8
        for (int ks = 0; ks < 128; ++ks) { const bf16x8 xf = *(const bf16x8*)(xrow + (size_t)(ks >> 2) * C_INP + 32 * (ks & 3));
            a0 = mfma16(*(const bf16x8*)(wrow0 + 32 * ks), xf, a0); a1 = mfma16(*(const bf16x8*)(wrow1 + 32 * ks), xf, a1); }
#pragma unroll
        for (int cg = 0; cg < 2; ++cg) { const int j0 = 32 * c.wave + 16 * cg + 4 * g4; const f32x4 b = *(const f32x4*)(B1 + j0); const f32x4 a = (cg ? a1 : a0) + b;
            v2u w; w.x = cvtpk(gelu_tanh(a[0]), gelu_tanh(a[1])); w.y = cvtpk(gelu_tanh(a[2]), gelu_tanh(a[3])); *(LAS v2u*)(Hs + qi * 528 + j0 * 2) = w; }
        __syncthreads();
        f32x4 o = (f32x4){0.f, 0.f, 0.f, 0.f};
        const bf16* w2row = W2T + (size_t)(16 * c.wave + qi) * 256 + 8 * g4;
#pragma unroll
        for (int k2 = 0; k2 < 8; ++k2) o = mfma16(*(const bf16x8*)(w2row + 32 * k2), *(const LAS bf16x8*)(Hs + qi * 528 + (32 * k2 + 8 * g4) * 2), o);
        const int n = n0 + qi; if (n == 511) o = (f32x4){0.f, 0.f, 0.f, 0.f};
        v2u w; w.x = cvtpk(o[0], o[1]); w.y = cvtpk(o[2], o[3]);
        *(v2u*)((bf16*)(c.ws + (tensor ? WS_CV : WS_CK)) + (size_t)(g * 512 + n) * 128 + 16 * c.wave + 4 * g4) = w;
        __syncthreads();
    }
}

#define NSA_UNIT_SETUP() \
      \
      \
    const int ux = u & 255, g = (ux & 7) >> 1, uidx = (ux >> 3) + 32 * (ux & 1), tb = (u & 256) ? 127 - uidx : uidx, t0 = 64 * tb; int qt[2]; const bf16* qrow[2]; bf16x8 qf[2][4]; \
    _Pragma("unroll") for (int qg = 0; qg < 2; ++qg) { qt[qg] = t0 + 8 * c.wave + 4 * qg + (G.qi >> 2); qrow[qg] = P + (size_t)qt[qg] * C_INP; \
        _Pragma("unroll") for (int ks = 0; ks < 4; ++ks) qf[qg][ks] = *(const bf16x8*)(qrow[qg] + (4 * g + (G.qi & 3)) * 128 + 32 * ks + 8 * G.g4); } \
    float m[2] = {-1e30f, -1e30f}, l[2] = {0.f, 0.f}; f32x4 o[2][8]; \
    _Pragma("unroll") for (int qg = 0; qg < 2; ++qg) _Pragma("unroll") for (int db = 0; db < 8; ++db) o[qg][db] = (f32x4){0.f, 0.f, 0.f, 0.f};

__device__ __forceinline__ void phase_nsa_window(const Ctx& c) {
    const bf16* P = (const bf16*)(c.ws + WS_P); bf16* OACC = (bf16*)(c.ws + WS_OACC);
    const LaneGeo G = lane_geo(c.lane);
    for (int u = c.bid; u < 512; u += c.G) {
        NSA_UNIT_SETUP();
        const bf16* kb = P + 4096 + g * 128; const bf16* vb = P + 4608 + g * 128;
        const int Tf = tb >= 8 ? 0 : 8 - tb;
        { const int k0 = t0 - 512 + 64 * Tf; auto rp = [=](int row, const bf16*& kp, const bf16*& vp) -> void { kp = kb + (size_t)(k0 + row) * C_INP; vp = vb + (size_t)(k0 + row) * C_INP; };
          tile_dma(c.lds + ATT_K0, c.lds + ATT_V0, rp, c.wave, c.lane); }
        TILE_SYNC();
        for (int T = Tf; T <= 8; ++T) {
            const int cur = (T - Tf) & 1, k0 = t0 - 512 + 64 * T;
            if (T < 8) { const int k1 = k0 + 64; auto rp = [=](int row, const bf16*& kp, const bf16*& vp) -> void { kp = kb + (size_t)(k1 + row) * C_INP; vp = vb + (size_t)(k1 + row) * C_INP; }; tile_dma(c.lds + (cur ? ATT_K0 : ATT_K1), c.lds + (cur ? ATT_V0 : ATT_V1), rp, c.wave, c.lane); }
            const int dq0 = qt[0] - k0, dq1 = qt[1] - k0;
            auto mask = [=](int qg, int key) -> bool { return (unsigned)((qg ? dq1 : dq0) - key) < 512u; };
            attn_tile(c.lds + (cur ? ATT_K1 : ATT_K0), c.lds + (cur ? ATT_V1 : ATT_V0), G, qf, m, l, o, T == 0 || T == 8, mask);
            TILE_SYNC();
        }
#pragma unroll
        for (int qg = 0; qg < 2; ++qg) { float lt = l[qg]; lt += __shfl_xor(lt, 16); lt += __shfl_xor(lt, 32);
            const int h = 4 * g + (G.qi & 3); const float sc = sigmoid_f(bf2f(qrow[qg][5120 + 3 * h + 2])) / lt;
            bf16* dst = OACC + (size_t)qt[qg] * C_OUT + h * 128 + 4 * G.g4;
#pragma unroll
            for (int db = 0; db < 8; ++db) { v2u w; w.x = cvtpk(o[qg][db][0] * sc, o[qg][db][1] * sc); w.y = cvtpk(o[qg][db][2] * sc, o[qg][db][3] * sc); *(v2u*)(dst + 16 * db) = w; } }
    }
}
constexpr int IMP_LD = 132;
__device__ __forceinline__ void phase_nsa_cmp(const Ctx& c) {
    const bf16* P = (const bf16*)(c.ws + WS_P); bf16* OACC = (bf16*)(c.ws + WS_OACC); unsigned* BM = (unsigned*)(c.ws + WS_BM);
    const bf16* CK = (const bf16*)(c.ws + WS_CK); const bf16* CV = (const bf16*)(c.ws + WS_CV);
    const LaneGeo G = lane_geo(c.lane);
    LAS float* imp = (LAS float*)(c.lds + ATT_X);
    for (int u = c.bid; u < 512; u += c.G) {
        NSA_UNIT_SETUP();
        const bf16* kb = CK + (size_t)g * 512 * 128; const bf16* vb = CV + (size_t)g * 512 * 128;
        const int ncmax = ((t0 + 32) >> 4) + 1, NT = (ncmax + 63) >> 6;
        int nmax[2]; float gate[2];
#pragma unroll
        for (int qg = 0; qg < 2; ++qg) { nmax[qg] = qt[qg] >= 31 ? ((qt[qg] - 31) >> 4) : -1; gate[qg] = sigmoid_f(bf2f(qrow[qg][5120 + 3 * (4 * g + (G.qi & 3)) + 0])); }
        for (int i = c.tid; i < 64 * IMP_LD; i += NTHREADS) imp[i] = 0.f;
        { auto rp = [=](int row, const bf16*& kp, const bf16*& vp) -> void { kp = kb + (size_t)row * 128; vp = vb + (size_t)row * 128; };
          tile_dma(c.lds + ATT_K0, c.lds + ATT_V0, rp, c.wave, c.lane); }
        TILE_SYNC();
        for (int T = 0; T < NT; ++T) {
            const int cur = T & 1, n0 = 64 * T;
            if (T + 1 < NT) { const int n1 = n0 + 64; auto rp = [=](int row, const bf16*& kp, const bf16*& vp) -> void { kp = kb + (size_t)(n1 + row) * 128; vp = vb + (size_t)(n1 + row) * 128; }; tile_dma(c.lds + (cur ? ATT_K0 : ATT_K1), c.lds + (cur ? ATT_V0 : ATT_V1), rp, c.wave, c.lane); }
            const int d0 = nmax[0] - n0, d1 = nmax[1] - n0;
            auto mask = [=](int qg, int key) -> bool { return key <= (qg ? d1 : d0); };
            attn_tile(c.lds + (cur ? ATT_K1 : ATT_K0), c.lds + (cur ? ATT_V1 : ATT_V0), G, qf, m, l, o, true, mask);
            TILE_SYNC();
        }
        float linv[2];
#pragma unroll
        for (int qg = 0; qg < 2; ++qg) { float lt = l[qg]; lt += __shfl_xor(lt, 16); lt += __shfl_xor(lt, 32); linv[qg] = lt > 0.f ? 1.0f / lt : 0.f; }
#pragma unroll
        for (int qg = 0; qg < 2; ++qg) { const int h = 4 * g + (G.qi & 3); const float sc = gate[qg] * linv[qg];
            bf16* dst = OACC + (size_t)qt[qg] * C_OUT + h * 128 + 4 * G.g4;
#pragma unroll
            for (int db = 0; db < 8; ++db) { const v2u old = *(const v2u*)(dst + 16 * db);
                v2u w; w.x = cvtpk(bflo(old.x) + o[qg][db][0] * sc, bfhi(old.x) + o[qg][db][1] * sc); w.y = cvtpk(bflo(old.y) + o[qg][db][2] * sc, bfhi(old.y) + o[qg][db][3] * sc); *(v2u*)(dst + 16 * db) = w; } }
        { auto rp = [=](int row, const bf16*& kp, const bf16*& vp) -> void { kp = kb + (size_t)row * 128; vp = vb + (size_t)row * 128; };
          tile_dma(c.lds + ATT_K0, c.lds + ATT_V0, rp, c.wave, c.lane); }
        TILE_SYNC();
        for (int T = 0; T < NT; ++T) {
            const int cur = T & 1, n0 = 64 * T;
            if (T + 1 < NT) { const int n1 = n0 + 64; auto rp = [=](int row, const bf16*& kp, const bf16*& vp) -> void { kp = kb + (size_t)(n1 + row) * 128; vp = vb + (size_t)(n1 + row) * 128; }; tile_dma(c.lds + (cur ? ATT_K0 : ATT_K1), c.lds + (cur ? ATT_V0 : ATT_V1), rp, c.wave, c.lane); }
            const int d0 = nmax[0] - n0, d1 = nmax[1] - n0;
            auto mask = [=](int qg, int key) -> bool { return key <= (qg ? d1 : d0); };
            f32x4 s[2][4];
            attn_scores(s, c.lds + (cur ? ATT_K1 : ATT_K0), G, qf, true, mask);
#pragma unroll
            for (int qg = 0; qg < 2; ++qg)
#pragma unroll
                for (int kg = 0; kg < 4; ++kg) {
                    const float p0 = __builtin_amdgcn_exp2f(s[qg][kg][0] - m[qg]), p1 = __builtin_amdgcn_exp2f(s[qg][kg][1] - m[qg]), p2 = __builtin_amdgcn_exp2f(s[qg][kg][2] - m[qg]), p3 = __builtin_amdgcn_exp2f(s[qg][kg][3] - m[qg]);
                    float sa = ((p0 + p1) + (p2 + p3)) * linv[qg], sb = p3 * linv[qg];
                    sa += __shfl_xor(sa, 1); sa += __shfl_xor(sa, 2); sb += __shfl_xor(sb, 1); sb += __shfl_xor(sb, 2);
                    if ((G.qi & 3) == 0) { const int tl = 8 * c.wave + 4 * qg + (G.qi >> 2), bA = 16 * T + 4 * kg + G.g4;
                        __hip_atomic_fetch_add(imp + tl * IMP_LD + bA, sa, __ATOMIC_RELAXED, __HIP_MEMORY_SCOPE_WORKGROUP);
                        if (bA + 1 < 128) __hip_atomic_fetch_add(imp + tl * IMP_LD + bA + 1, sb, __ATOMIC_RELAXED, __HIP_MEMORY_SCOPE_WORKGROUP); }
                }
            TILE_SYNC();
        }
        for (int ti = 0; ti < 8; ++ti) {
            const int tl = 8 * c.wave + ti, t = t0 + tl, curb = t >> 6; float sc[2];
#pragma unroll
            for (int i = 0; i < 2; ++i) { const int mb = c.lane + 64 * i; const bool forced = (mb == 0) || (mb == curb) || (mb == curb - 1);
                sc[i] = (mb <= curb) ? imp[tl * IMP_LD + mb] + (forced ? 1e4f : 0.f) : -__builtin_inff(); }
            const unsigned k0 = sc[0] >= 0.f ? __builtin_bit_cast(unsigned, sc[0]) + 1u : 0u, k1 = sc[1] >= 0.f ? __builtin_bit_cast(unsigned, sc[1]) + 1u : 0u;
            unsigned thr = 0u;
#pragma unroll 1
            for (int bit = 30; bit >= 0; --bit) { const unsigned cand = thr | (1u << bit);
                const int cnt = __popcll(__ballot(k0 >= cand)) + __popcll(__ballot(k1 >= cand)); if (cnt >= 16) thr = cand; }
            const unsigned long long gt0 = __ballot(k0 > thr), gt1 = __ballot(k1 > thr), eq0 = __ballot(k0 == thr && k0 != 0u), eq1 = __ballot(k1 == thr && k1 != 0u);
            const int need = 16 - (__popcll(gt0) + __popcll(gt1)); const unsigned long long below = (1ull << c.lane) - 1ull;
            const bool sel0 = (k0 > thr) || ((k0 == thr && k0 != 0u) && __popcll(eq0 & below) < need), sel1 = (k1 > thr) || ((k1 == thr && k1 != 0u) && __popcll(eq0) + __popcll(eq1 & below) < need);
            const unsigned long long mk0 = __ballot(sel0), mk1 = __ballot(sel1);
            if (c.lane == 0) *(v4u*)(BM + ((size_t)g * S_ + t) * 4) = (v4u){(unsigned)mk0, (unsigned)(mk0 >> 32), (unsigned)mk1, (unsigned)(mk1 >> 32)};
        }
        __syncthreads();
    }
}
__device__ __forceinline__ void phase_nsa_sel(const Ctx& c) {
    const bf16* P = (const bf16*)(c.ws + WS_P); const bf16* OACC = (const bf16*)(c.ws + WS_OACC); bf16* CAT = (bf16*)(c.ws + WS_CAT); const unsigned* BM = (const unsigned*)(c.ws + WS_BM);
    const LaneGeo G = lane_geo(c.lane);
    LAS unsigned* bms = (LAS unsigned*)(c.lds + ATT_X);
    for (int u = c.bid; u < 512; u += c.G) {
        NSA_UNIT_SETUP();
        const bf16* kb = P + 3072 + g * 128; const bf16* vb = P + 3584 + g * 128;
        if (c.tid < 256) bms[c.tid] = BM[((size_t)g * S_ + t0) * 4 + c.tid];
        { auto rp = [=](int row, const bf16*& kp, const bf16*& vp) -> void { kp = kb + (size_t)row * C_INP; vp = vb + (size_t)row * C_INP; };
          tile_dma(c.lds + ATT_K0, c.lds + ATT_V0, rp, c.wave, c.lane); }
        TILE_SYNC();
        const int tl0 = 8 * c.wave + (G.qi >> 2), tl1 = tl0 + 4;
        for (int T = 0; T <= tb; ++T) {
            const int cur = T & 1, k0 = 64 * T;
            if (T < tb) { const int k1 = k0 + 64; auto rp = [=](int row, const bf16*& kp, const bf16*& vp) -> void { kp = kb + (size_t)(k1 + row) * C_INP; vp = vb + (size_t)(k1 + row) * C_INP; }; tile_dma(c.lds + (cur ? ATT_K0 : ATT_K1), c.lds + (cur ? ATT_V0 : ATT_V1), rp, c.wave, c.lane); }
            const bool b0 = (bms[tl0 * 4 + (T >> 5)] >> (T & 31)) & 1u, b1 = (bms[tl1 * 4 + (T >> 5)] >> (T & 31)) & 1u;
            if (__ballot(b0 || b1) != 0ull) {
                const int dq0 = b0 ? qt[0] - k0 : -1, dq1 = b1 ? qt[1] - k0 : -1;
                auto mask = [=](int qg, int key) -> bool { return key <= (qg ? dq1 : dq0); };
                attn_tile(c.lds + (cur ? ATT_K1 : ATT_K0), c.lds + (cur ? ATT_V1 : ATT_V0), G, qf, m, l, o, true, mask);
            }
            TILE_SYNC();
        }
#pragma unroll
        for (int qg = 0; qg < 2; ++qg) { float lt = l[qg]; lt += __shfl_xor(lt, 16); lt += __shfl_xor(lt, 32);
            const int h = 4 * g + (G.qi & 3); const float sc = sigmoid_f(bf2f(qrow[qg][5120 + 3 * h + 1])) / lt;
            const bf16* src = OACC + (size_t)qt[qg] * C_OUT + h * 128 + 4 * G.g4; bf16* dst = CAT + (size_t)qt[qg] * C_OUT + h * 128 + 4 * G.g4;
#pragma unroll
            for (int db = 0; db < 8; ++db) { const v2u old = *(const v2u*)(src + 16 * db);
                v2u w; w.x = cvtpk(bflo(old.x) + o[qg][db][0] * sc, bfhi(old.x) + o[qg][db][1] * sc); w.y = cvtpk(bflo(old.y) + o[qg][db][2] * sc, bfhi(old.y) + o[qg][db][3] * sc); *(v2u*)(dst + 16 * db) = w; } }
    }
}

template <class RP1> __device__ __forceinline__ void img_dma(LAS unsigned char* img, int nrows, const RP1& rp, int wave, int lane) {
    for (int p = wave; p < nrows / 4; p += 8) { const int row = 4 * p + (lane >> 4), ch = (lane & 15) ^ (((row & 3) << 2) | ((row >> 2) & 3));
        __builtin_amdgcn_global_load_lds((const unsigned*)(rp(row) + 8 * ch), (LAS unsigned*)(img + 1024 * p), 16, 0, 0); }
}
__device__ __forceinline__ int tr_off(int rb4, int cblk, int qi) { const int q = qi >> 2, p = qi & 3; return 256 * (rb4 + q) + 16 * ((2 * cblk + (p >> 1)) ^ ((q << 2) | ((rb4 >> 2) & 3))) + 8 * (p & 1); }
__device__ __forceinline__ bf16x8 tr_frag(const LAS unsigned char* img, int rbA, int rbB, int cblk, int qi) {
    const s16x4 lo = vtr(img + tr_off(rbA, cblk, qi)), hi = vtr(img + tr_off(rbB, cblk, qi)); return __builtin_shufflevector(lo, hi, 0, 1, 2, 3, 4, 5, 6, 7); }

constexpr size_t DST_O_FLOATS = (size_t)S_ * 1024;
__device__ __forceinline__ void phase_dil(const Ctx& c, int pi) {
    const bf16* P = (const bf16*)(c.ws + WS_P); bf16* CAT = (bf16*)(c.ws + WS_CAT); float* DO = (float*)(c.ws + WS_DST); float* DML = DO + DST_O_FLOATS;
    const LaneGeo G = lane_geo(c.lane);
    const int dil = pi == 0 ? 1 : (pi == 1 ? 4 : 16), nper = 32 / dil;
    for (int u = c.bid; u < 256; u += c.G) {
        const int h = u & 7, other = u >> 3, r = other / nper, uu = other % nper;
        int qidx[2], qt[2]; bf16x8 qf[2][4];
#pragma unroll
        for (int qg = 0; qg < 2; ++qg) { qidx[qg] = 256 * uu + 32 * c.wave + 16 * qg + G.qi; qt[qg] = qidx[qg] * dil + r;
#pragma unroll
            for (int ks = 0; ks < 4; ++ks) qf[qg][ks] = *(const bf16x8*)(P + (size_t)qt[qg] * AB_IN + 6144 + h * 128 + 32 * ks + 8 * G.g4); }
        float m[2], l[2]; f32x4 o[2][8];
#pragma unroll
        for (int qg = 0; qg < 2; ++qg) {
            if (pi == 0) { m[qg] = -1e30f; l[qg] = 0.f;
#pragma unroll
                for (int db = 0; db < 8; ++db) o[qg][db] = (f32x4){0.f, 0.f, 0.f, 0.f}; }
            else { const size_t sb = (size_t)qt[qg] * 8 + h; m[qg] = DML[sb * 2]; l[qg] = G.g4 == 0 ? DML[sb * 2 + 1] : 0.f;
#pragma unroll
                for (int db = 0; db < 8; ++db) o[qg][db] = *(const f32x4*)(DO + sb * 128 + 16 * db + 4 * G.g4); }
        }
        const bf16* kb = P + 7168 + h * 128; const bf16* vb = P + 8192 + h * 128;
        const int Tf = uu == 0 ? 2 : 0;
        { const int k0 = 256 * uu - 128 + 64 * Tf; auto rp = [=](int row, const bf16*& kp, const bf16*& vp) -> void { const size_t tok = (size_t)((k0 + row) * dil + r); kp = kb + tok * AB_IN; vp = vb + tok * AB_IN; };
          tile_dma(c.lds + ATT_K0, c.lds + ATT_V0, rp, c.wave, c.lane); }
        TILE_SYNC();
        for (int T = Tf; T < 6; ++T) {
            const int cur = (T - Tf) & 1, k0 = 256 * uu - 128 + 64 * T;
            if (T < 5) { const int k1 = k0 + 64; auto rp = [=](int row, const bf16*& kp, const bf16*& vp) -> void { const size_t tok = (size_t)((k1 + row) * dil + r); kp = kb + tok * AB_IN; vp = vb + tok * AB_IN; };
                tile_dma(c.lds + (cur ? ATT_K0 : ATT_K1), c.lds + (cur ? ATT_V0 : ATT_V1), rp, c.wave, c.lane); }
            if (64 * T + 63 >= 32 * c.wave && 64 * T <= 32 * c.wave + 159) {
                const int dq0 = qidx[0] - k0, dq1 = qidx[1] - k0;
                auto mask = [=](int qg, int key) -> bool { return (unsigned)((qg ? dq1 : dq0) - key) < 129u; };
                attn_tile(c.lds + (cur ? ATT_K1 : ATT_K0), c.lds + (cur ? ATT_V1 : ATT_V0), G, qf, m, l, o, true, mask);
            }
            TILE_SYNC();
        }
#pragma unroll
        for (int qg = 0; qg < 2; ++qg) { float lt = l[qg]; lt += __shfl_xor(lt, 16); lt += __shfl_xor(lt, 32);
            if (pi < 2) { const size_t sb = (size_t)qt[qg] * 8 + h; if (G.g4 == 0) { DML[sb * 2] = m[qg]; DML[sb * 2 + 1] = lt; }
#pragma unroll
                for (int db = 0; db < 8; ++db) *(f32x4*)(DO + sb * 128 + 16 * db + 4 * G.g4) = o[qg][db]; }
            else { const float sc = 1.0f / lt; bf16* dst = CAT + (size_t)qt[qg] * AB_OUT + 2048 + h * 128 + 4 * G.g4;
#pragma unroll
                for (int db = 0; db < 8; ++db) { v2u w; w.x = cvtpk(o[qg][db][0] * sc, o[qg][db][1] * sc); w.y = cvtpk(o[qg][db][2] * sc, o[qg][db][3] * sc); *(v2u*)(dst + 16 * db) = w; } }
        }
    }
}

constexpr int RK_IMG = 0, RV_IMG0 = 32768, RV_IMG1 = 65536;
__device__ __forceinline__ void phase_ret_kv(const Ctx& c) {
    const bf16* P = (const bf16*)(c.ws + WS_P); float* KV = (float*)(c.ws + WS_KV);
    const int qi = c.lane & 15, g4 = c.lane >> 4;
    for (int u = c.bid; u < 512; u += c.G) {
        const int h = u >> 6, n = u & 63; const float lg = ret_log_gamma(h);
        { const bf16* vsrc = P + (size_t)(128 * n) * AB_IN + 2048 + h * 256;
          auto rp0 = [=](int row) -> const bf16* { return vsrc + (size_t)row * AB_IN; }; auto rp1 = [=](int row) -> const bf16* { return vsrc + (size_t)row * AB_IN + 128; };
          img_dma(c.lds + RV_IMG0, 128, rp0, c.wave, c.lane); img_dma(c.lds + RV_IMG1, 128, rp1, c.wave, c.lane); }
#pragma unroll
        for (int i = 0; i < 4; ++i) { const int ci = c.tid + 512 * i, row = ci >> 4, ch = ci & 15;
            const v4u v = *(const v4u*)(P + (size_t)(128 * n + row) * AB_IN + 1024 + h * 128 + 8 * ch); const float zs = RET_SCALE * __expf(lg * (float)(127 - row));
            v4u w; w.x = cvtpk(bflo(v.x) * zs, bfhi(v.x) * zs); w.y = cvtpk(bflo(v.y) * zs, bfhi(v.y) * zs); w.z = cvtpk(bflo(v.z) * zs, bfhi(v.z) * zs); w.w = cvtpk(bflo(v.w) * zs, bfhi(v.w) * zs);
            *(LAS v4u*)(c.lds + RK_IMG + off_b(row, ch)) = w; }
        TILE_SYNC();
        f32x4 acc[16];
#pragma unroll
        for (int i = 0; i < 16; ++i) acc[i] = (f32x4){0.f, 0.f, 0.f, 0.f};
#pragma unroll
        for (int ks = 0; ks < 4; ++ks) {
            const bf16x8 kf = tr_frag(c.lds + RK_IMG, 32 * ks + 8 * g4, 32 * ks + 8 * g4 + 4, c.wave, qi);
#pragma unroll
            for (int dvb = 0; dvb < 16; ++dvb) { const bf16x8 vf = tr_frag(c.lds + (dvb < 8 ? RV_IMG0 : RV_IMG1), 32 * ks + 8 * g4, 32 * ks + 8 * g4 + 4, dvb & 7, qi);
                acc[dvb] = mfma16(vf, kf, acc[dvb]); }
            asm volatile("" ::: "memory");
        }
        float* dst = KV + ((size_t)(h * 64 + n) * 128 + 16 * c.wave + qi) * 256 + 4 * g4;
#pragma unroll
        for (int dvb = 0; dvb < 16; ++dvb) *(f32x4*)(dst + 16 * dvb) = acc[dvb];
        __syncthreads();
    }
}
__device__ __forceinline__ void phase_ret_scan(const Ctx& c) {
    const float* KV = (const float*)(c.ws + WS_KV); bf16* PV = (bf16*)(c.ws + WS_PREV);
    for (int it = c.bid * NTHREADS + c.tid; it < 8 * 128 * 64; it += c.G * NTHREADS) {
        const int h = it >> 13, rem = it & 8191; const float cd = __expf(ret_log_gamma(h) * 128.0f);
        const size_t off = (size_t)h * 64 * 32768 + (size_t)rem * 4;
        f32x4 st = (f32x4){0.f, 0.f, 0.f, 0.f};
#pragma unroll 4
        for (int n = 0; n < 64; ++n) { const f32x4 kv = *(const f32x4*)(KV + off + (size_t)n * 32768);
            v2u w; w.x = cvtpk(st[0], st[1]); w.y = cvtpk(st[2], st[3]); *(v2u*)(PV + off + (size_t)n * 32768) = w; st = st * cd + kv; }
    }
}
constexpr int RO_PRV0 = 0, RO_PRV1 = 32768, RO_K = 65536, RO_V0 = 0, RO_V1 = 32768;
__device__ __forceinline__ void phase_ret_out(const Ctx& c) {
    const bf16* P = (const bf16*)(c.ws + WS_P); const bf16* PV = (const bf16*)(c.ws + WS_PREV); bf16* CAT = (bf16*)(c.ws + WS_CAT);
    const int qi = c.lane & 15, g4 = c.lane >> 4;
    int koff[4];
    { const int kx = ((qi & 3) << 2) | (qi >> 2);
#pragma unroll
      for (int ks = 0; ks < 4; ++ks) koff[ks] = 256 * qi + 16 * ((4 * ks + g4) ^ kx); }
    for (int u = c.bid; u < 512; u += c.G) {
        const int h = u >> 6, n = u & 63, q = 16 * c.wave + qi, tok = 128 * n + q; const float lg = ret_log_gamma(h), lg2 = lg * 1.4426950408889634f;
        bf16x8 qf[4];
#pragma unroll
        for (int ks = 0; ks < 4; ++ks) qf[ks] = *(const bf16x8*)(P + (size_t)tok * AB_IN + h * 128 + 32 * ks + 8 * g4);
        { const bf16* ps = PV + (size_t)(h * 64 + n) * 32768; const bf16* ksrc = P + (size_t)(128 * n) * AB_IN + 1024 + h * 128;
          auto rp0 = [=](int row) -> const bf16* { return ps + (size_t)row * 256; }; auto rp1 = [=](int row) -> const bf16* { return ps + (size_t)row * 256 + 128; };
          auto rpk = [=](int row) -> const bf16* { return ksrc + (size_t)row * AB_IN; };
          img_dma(c.lds + RO_PRV0, 128, rp0, c.wave, c.lane); img_dma(c.lds + RO_PRV1, 128, rp1, c.wave, c.lane); img_dma(c.lds + RO_K, 128, rpk, c.wave, c.lane); }
        TILE_SYNC();
        f32x4 acc[16];
#pragma unroll
        for (int i = 0; i < 16; ++i) acc[i] = (f32x4){0.f, 0.f, 0.f, 0.f};
#pragma unroll
        for (int ks = 0; ks < 4; ++ks) {
#pragma unroll
            for (int dvb = 0; dvb < 16; ++dvb) { const bf16x8 pf = tr_frag(c.lds + (dvb < 8 ? RO_PRV0 : RO_PRV1), 32 * ks + 8 * g4, 32 * ks + 8 * g4 + 4, dvb & 7, qi);
                acc[dvb] = mfma16(pf, qf[ks], acc[dvb]); }
            asm volatile("" ::: "memory");
        }
        { const float xi = __builtin_amdgcn_exp2f(lg2 * (float)(q + 1));
#pragma unroll
          for (int i = 0; i < 16; ++i) acc[i] *= xi; }
        __syncthreads();
        { const bf16* vsrc = P + (size_t)(128 * n) * AB_IN + 2048 + h * 256;
          auto rp0 = [=](int row) -> const bf16* { return vsrc + (size_t)row * AB_IN; }; auto rp1 = [=](int row) -> const bf16* { return vsrc + (size_t)row * AB_IN + 128; };
          img_dma(c.lds + RO_V0, 128, rp0, c.wave, c.lane); img_dma(c.lds + RO_V1, 128, rp1, c.wave, c.lane); }
        bf16x8 pb[4];
#pragma unroll
        for (int k2 = 0; k2 < 4; ++k2) {
            f32x4 s0 = (f32x4){0.f, 0.f, 0.f, 0.f}, s1 = (f32x4){0.f, 0.f, 0.f, 0.f};
            if (2 * k2 <= c.wave) {
#pragma unroll
                for (int ks = 0; ks < 4; ++ks) { s0 = mfma16(*(const LAS bf16x8*)(c.lds + RO_K + 4096 * (2 * k2) + koff[ks]), qf[ks], s0); s1 = mfma16(*(const LAS bf16x8*)(c.lds + RO_K + 4096 * (2 * k2 + 1) + koff[ks]), qf[ks], s1); }
#pragma unroll
                for (int r = 0; r < 4; ++r) { const int ka = 32 * k2 + 4 * g4 + r, kb2 = ka + 16;
                    s0[r] = ka <= q ? s0[r] * RET_SCALE * __builtin_amdgcn_exp2f(lg2 * (float)(q - ka)) : 0.f; s1[r] = kb2 <= q ? s1[r] * RET_SCALE * __builtin_amdgcn_exp2f(lg2 * (float)(q - kb2)) : 0.f; }
            }
            v4u w; w.x = cvtpk(s0[0], s0[1]); w.y = cvtpk(s0[2], s0[3]); w.z = cvtpk(s1[0], s1[1]); w.w = cvtpk(s1[2], s1[3]); pb[k2] = __builtin_bit_cast(bf16x8, w);
        }
        TILE_SYNC();
#pragma unroll
        for (int k2 = 0; k2 < 4; ++k2) {
            if (2 * k2 <= c.wave) {
#pragma unroll
                for (int dvb = 0; dvb < 16; ++dvb) { const bf16x8 vf = tr_frag(c.lds + (dvb < 8 ? RO_V0 : RO_V1), 32 * k2 + 4 * g4, 32 * k2 + 16 + 4 * g4, dvb & 7, qi);
                    acc[dvb] = mfma16(vf, pb[k2], acc[dvb]); }
            }
            asm volatile("" ::: "memory");
        }
        float sm = 0.f;
#pragma unroll
        for (int i = 0; i < 16; ++i) sm += (acc[i][0] + acc[i][1]) + (acc[i][2] + acc[i][3]);
        sm += __shfl_xor(sm, 16); sm += __shfl_xor(sm, 32);
        const float mean = sm * (1.0f / 256.0f); float vs = 0.f;
#pragma unroll
        for (int i = 0; i < 16; ++i) { acc[i] = acc[i] - mean; vs += (acc[i][0] * acc[i][0] + acc[i][1] * acc[i][1]) + (acc[i][2] * acc[i][2] + acc[i][3] * acc[i][3]); }
        vs += __shfl_xor(vs, 16); vs += __shfl_xor(vs, 32);
        const float rs = 1.0f / sqrtf(vs * (1.0f / 256.0f) + NORM_EPS);
        const bf16* gsrc = P + (size_t)tok * AB_IN + 4096 + h * 256 + 4 * g4; bf16* dst = CAT + (size_t)tok * AB_OUT + h * 256 + 4 * g4;
#pragma unroll
        for (int dvb = 0; dvb < 16; ++dvb) { const v2u gv = *(const v2u*)(gsrc + 16 * dvb); const float g0 = bflo(gv.x), g1 = bfhi(gv.x), g2 = bflo(gv.y), g3 = bfhi(gv.y);
            v2u w; w.x = cvtpk(g0 * sigmoid_f(g0) * acc[dvb][0] * rs, g1 * sigmoid_f(g1) * acc[dvb][1] * rs); w.y = cvtpk(g2 * sigmoid_f(g2) * acc[dvb][2] * rs, g3 * sigmoid_f(g3) * acc[dvb][3] * rs);
            *(v2u*)(dst + 16 * dvb) = w; }
        __syncthreads();
    }
}

struct Args { const float* in[16]; float* out; unsigned char* ws; int ph_lo, ph_hi; };
__device__ __forceinline__ Ctx make_ctx(const Args& args, LAS unsigned char* lds, int wave_s) {
    Ctx c; c.lds = lds;
    const float* const* in = args.in;
    c.x = in[0]; c.pos = (const int*)in[1]; c.norm_g = in[2]; c.w1 = in[3]; c.w3 = in[4]; c.w2 = in[5]; c.ab_in = in[6]; c.ab_out = in[7];
    c.c_in = in[8]; c.c_out = in[9]; c.ck_w1 = in[10]; c.ck_w2 = in[11]; c.cv_w1 = in[12]; c.cv_w2 = in[13]; c.pe_k = in[14]; c.pe_v = in[15];
    float* out = args.out; unsigned char* ws = args.ws; asm volatile("" : "+s"(out), "+s"(ws));
    c.out = out; c.ws = ws;
    int lane, bid = blockIdx.x, G = gridDim.x;
    asm volatile("v_mbcnt_lo_u32_b32 %0, -1, 0\n\tv_mbcnt_hi_u32_b32 %0, -1, %0" : "=v"(lane));
    asm volatile("" : "+s"(wave_s), "+s"(bid), "+s"(G));
    c.lane = lane; c.wave = wave_s; c.tid = wave_s * 64 + lane; c.bid = bid; c.G = G; c.gw = c.bid * NWAVES + c.wave; c.NGW = c.G * NWAVES;
    return c;
}
__global__ void __launch_bounds__(NTHREADS, 2) mk_fwd(Args args) {
    extern __shared__ __attribute__((aligned(16))) unsigned char lds_raw[];
    LAS unsigned char* const lds = (LAS unsigned char*)lds_raw;
    for (int u = threadIdx.x; u < (LDS_BYTES - RING_BYTES) / 4; u += NTHREADS) ((LAS unsigned*)(lds + RING_BYTES))[u] = 0u;
    __syncthreads();
    const int lo = args.ph_lo, hi = args.ph_hi; const int wave_s = __builtin_amdgcn_readfirstlane(threadIdx.x >> 6);
#if MK_FUSED
    XcdBarrier bar = xcd_barrier_post((unsigned*)(args.ws + WS_CTL) + CW_BAR, (volatile LAS unsigned*)(lds + MISC_OFF) + 8);
#define GRID_BAR() xcd_barrier(bar)
#else
#define GRID_BAR() do { } while (0)
#endif
#define IN(k) (lo <= (k) && (k) < hi)
#define SEAM(k) do { if (IN(k) && IN((k) + 1)) GRID_BAR(); } while (0)
#define CTX() const Ctx c = make_ctx(args, lds, wave_s)
#define WSP(T, off) ((T*)(c.ws + (off)))

    if (IN(0)) { for (int rep = 0; rep < (PROBE_DUP == 3 ? 2 : 1); ++rep) { CTX(); phase_prologue(c); } }
    SEAM(0);
#pragma unroll 1
    for (int L = 0; L < DEPTH; ++L) {
        const int base = 1 + 13 * L, jx = L >> 1; const bool odd = (L & 1) != 0;
        if (IN(base + 0)) { CTX(); pg8::Gemm g{WSP(bf16, WS_H), (const bf16*)(c.ws + WS_W13 + (size_t)(2 * L) * SZ_W13), S_, NUP, D_}; pg8::StaticOrder So; So.init(S_, NUP, c.G, c.bid);
            pg8::EpiSwiglu E{WSP(bf16, WS_P), DFF}; for (int rep = 0; rep < (PROBE_DUP == 1 ? 2 : 1); ++rep) pg8::gemm_phase<pg8::EpiSwiglu, pg8::StaticOrder, true, true>(c.lds, g, So, E, c.tid); }
        SEAM(base + 0);
        if (IN(base + 1)) { CTX(); pg8::Gemm g{WSP(bf16, WS_P), (const bf16*)(c.ws + WS_W2 + (size_t)(2 * L) * SZ_W2), S_, D_, DFF}; pg8::StaticOrder So; So.init(S_, D_, c.G, c.bid);
            pg8::EpiStore E{WSP(bf16, WS_Y), D_}; for (int rep = 0; rep < (PROBE_DUP == 1 ? 2 : 1); ++rep) pg8::gemm_phase<pg8::EpiStore, pg8::StaticOrder, true, true>(c.lds, g, So, E, c.tid); }
        SEAM(base + 1);
        if (IN(base + 2)) { CTX(); const float* ng = c.norm_g + (size_t)L * 6 * D_; phase_rowpass(c, ng + 1 * D_, 0.5f, ng + 2 * D_); }
        SEAM(base + 2);
        if (!odd) {
            if (IN(base + 3)) { CTX(); pg8::Gemm g{WSP(bf16, WS_H), (const bf16*)(c.ws + WS_ABIN + (size_t)jx * SZ_ABIN), S_, AB_IN, D_}; pg8::StaticOrder So; So.init(S_, AB_IN, c.G, c.bid);
                pg8::EpiStore E{WSP(bf16, WS_P), AB_IN}; for (int rep = 0; rep < (PROBE_DUP == 1 ? 2 : 1); ++rep) pg8::gemm_phase<pg8::EpiStore, pg8::StaticOrder, true, true>(c.lds, g, So, E, c.tid); }
            SEAM(base + 3);
            if (IN(base + 4)) { CTX(); phase_rope_even(c); }
            SEAM(base + 4);
            for (int rep = 0; rep < (PROBE_DUP == 2 ? 2 : 1); ++rep) {
            if (rep) GRID_BAR();
            if (IN(base + 5)) { { CTX(); phase_ret_kv(c); } { CTX(); phase_dil(c, 0); } }
            SEAM(base + 5);
            if (IN(base + 6)) { { CTX(); phase_ret_scan(c); } { CTX(); phase_dil(c, 1); } }
            SEAM(base + 6);
            if (IN(base + 7)) { { CTX(); phase_ret_out(c); } { CTX(); phase_dil(c, 2); } }
            }
            SEAM(base + 7);
            if (IN(base + 8)) { CTX(); pg8::Gemm g{WSP(bf16, WS_CAT), (const bf16*)(c.ws + WS_ABOUT + (size_t)jx * SZ_ABOUT), S_, D_, AB_OUT}; pg8::StaticOrder So; So.init(S_, D_, c.G, c.bid);
                pg8::EpiStore E{WSP(bf16, WS_Y), D_}; for (int rep = 0; rep < (PROBE_DUP == 1 ? 2 : 1); ++rep) pg8::gemm_phase<pg8::EpiStore, pg8::StaticOrder, true, true>(c.lds, g, So, E, c.tid); }
            SEAM(base + 8);
        } else {
            if (IN(base + 3)) { CTX(); pg8::Gemm g{WSP(bf16, WS_H), (const bf16*)(c.ws + WS_CIN + (size_t)jx * SZ_CIN), S_, C_INP, D_}; pg8::StaticOrder So; So.init(S_, C_INP, c.G, c.bid);
                pg8::EpiStore E{WSP(bf16, WS_P), C_INP}; for (int rep = 0; rep < (PROBE_DUP == 1 ? 2 : 1); ++rep) pg8::gemm_phase<pg8::EpiStore, pg8::StaticOrder, true, true>(c.lds, g, So, E, c.tid); }
            SEAM(base + 3);
            if (IN(base + 4)) { CTX(); phase_rope_odd(c); }
            SEAM(base + 4);
            for (int rep = 0; rep < (PROBE_DUP == 2 ? 2 : 1); ++rep) {
            if (rep) GRID_BAR();
            if (IN(base + 5)) { { CTX(); phase_compress(c, jx); } { CTX(); phase_nsa_window(c); } }
            SEAM(base + 5);
            if (IN(base + 6)) { CTX(); phase_nsa_cmp(c); }
            SEAM(base + 6);
            if (IN(base + 7)) { CTX(); phase_nsa_sel(c); }
            }
            SEAM(base + 7);
            if (IN(base + 8)) { CTX(); pg8::Gemm g{WSP(bf16, WS_CAT), (const bf16*)(c.ws + WS_COUT + (size_t)jx * SZ_COUT), S_, D_, C_OUT}; pg8::StaticOrder So; So.init(S_, D_, c.G, c.bid);
                pg8::EpiStore E{WSP(bf16, WS_Y), D_}; for (int rep = 0; rep < (PROBE_DUP == 1 ? 2 : 1); ++rep) pg8::gemm_phase<pg8::EpiStore, pg8::StaticOrder, true, true>(c.lds, g, So, E, c.tid); }
            SEAM(base + 8);
        }
        if (IN(base + 9)) { CTX(); const float* ng = c.norm_g + (size_t)L * 6 * D_; phase_rowpass(c, ng + 3 * D_, 1.0f, ng + 4 * D_); }
        SEAM(base + 9);
        if (IN(base + 10)) { CTX(); pg8::Gemm g{WSP(bf16, WS_H), (const bf16*)(c.ws + WS_W13 + (size_t)(2 * L + 1) * SZ_W13), S_, NUP, D_}; pg8::StaticOrder So; So.init(S_, NUP, c.G, c.bid);
            pg8::EpiSwiglu E{WSP(bf16, WS_P), DFF}; for (int rep = 0; rep < (PROBE_DUP == 1 ? 2 : 1); ++rep) pg8::gemm_phase<pg8::EpiSwiglu, pg8::StaticOrder, true, true>(c.lds, g, So, E, c.tid); }
        SEAM(base + 10);
        if (IN(base + 11)) { CTX(); pg8::Gemm g{WSP(bf16, WS_P), (const bf16*)(c.ws + WS_W2 + (size_t)(2 * L + 1) * SZ_W2), S_, D_, DFF}; pg8::StaticOrder So; So.init(S_, D_, c.G, c.bid);
            pg8::EpiStore E{WSP(bf16, WS_Y), D_}; for (int rep = 0; rep < (PROBE_DUP == 1 ? 2 : 1); ++rep) pg8::gemm_phase<pg8::EpiStore, pg8::StaticOrder, true, true>(c.lds, g, So, E, c.tid); }
        SEAM(base + 11);
        if (IN(base + 12)) { CTX(); const float* ng = c.norm_g + (size_t)L * 6 * D_; phase_rowpass(c, ng + 5 * D_, 0.5f, (L + 1 < DEPTH) ? ng + 6 * D_ : nullptr); }
        if (L + 1 < DEPTH) SEAM(base + 12);
    }
#undef IN
#undef SEAM
}

extern "C" void kernel_launch(void* const* d_in, const int* in_sizes, int n_in, void* d_out, int out_size, void* d_ws, size_t ws_size, hipStream_t stream) {
    static int grid = 0;
    if (grid == 0) {
        if (n_in != 16 || in_sizes[0] != S_ * D_ || out_size != S_ * D_ || ws_size < WS_END) { fprintf(stderr, "kernel_launch: unexpected shapes/workspace (n_in %d, in0 %d, out %d, ws %zu < %zu)\n", n_in, n_in > 0 ? in_sizes[0] : -1, out_size, ws_size, (size_t)WS_END); grid = -1; return; }
        int dev = 0, cus = 0;
        if (hipGetDevice(&dev) != hipSuccess || hipDeviceGetAttribute(&cus, hipDeviceAttributeMultiprocessorCount, dev) != hipSuccess) { grid = -1; return; }
        if (hipFuncSetAttribute((const void*)mk_fwd, hipFuncAttributeMaxDynamicSharedMemorySize, LDS_BYTES) != hipSuccess) { fprintf(stderr, "kernel_launch: hipFuncSetAttribute failed\n"); grid = -1; return; }
        int per_cu = 0;
        if (hipOccupancyMaxActiveBlocksPerMultiprocessor(&per_cu, (const void*)mk_fwd, NTHREADS, LDS_BYTES) != hipSuccess || per_cu < 1) fprintf(stderr, "kernel_launch: occupancy query says %d\n", per_cu);
        (void)hipGetLastError();
        grid = cus;
    }
    if (grid < 0) return;
    (void)hipMemsetAsync((char*)d_ws + WS_CTL, 0, CTL_ZERO_BYTES, stream);
    Args a{};
    for (int i = 0; i < 16; ++i) a.in[i] = (const float*)d_in[i];
    a.out = (float*)d_out; a.ws = (unsigned char*)d_ws;
#if MK_FUSED
    a.ph_lo = 0; a.ph_hi = N_PHASES;
    hipLaunchKernelGGL(mk_fwd, dim3(grid), dim3(NTHREADS), LDS_BYTES, stream, a);
#else
    for (int p = 0; p < N_PHASES; ++p) {
        a.ph_lo = p; a.ph_hi = p + 1;
        hipLaunchKernelGGL(mk_fwd, dim3(grid), dim3(NTHREADS), LDS_BYTES, stream, a);
    }
#endif
}
```
